# Optimizing an MI355X kernel written in HIP

```python
import jax, jax.numpy as jnp
from jax import lax
import numpy as np

D_MODEL = 1024
BATCH = 8
SEQ = 2048
DEPTH = 4
DEC_BATCH = 128
DEC_SEQ = 8
PAST_LEN = 16384
PAGE_SIZE = 128

D_MIX = D_MODEL
HEAD_DIM = 64
D_A = 3 * D_MIX // 8
D_B = 3 * D_MIX // 8
D_C = D_MIX - D_A - D_B
N_HEADS_B = D_B // HEAD_DIM
CONV_A_WIDTH = 3
CONV_C_WIDTH = 31
CHUNK = 128
D_PLE = 256
D_FF = -(-8 * D_MODEL // (3 * 256)) * 256
D_IN = 3 * D_A + 2 * D_B + 2 * D_C
SPLITS = [D_A, 2 * D_A, 3 * D_A, 3 * D_A + D_B, 3 * D_A + 2 * D_B]
EPS = 1e-6

kernel_name = 'hybrid_shortconv_chunkmlp_conformer_step'


def rmsnorm(x, g):
    xf = x.astype(jnp.float32)
    y = xf * lax.rsqrt(jnp.mean(xf * xf, axis=-1, keepdims=True) + EPS)
    return (y * g.astype(jnp.float32)).astype(x.dtype)


def layernorm(x, g, b):
    xf = x.astype(jnp.float32)
    mu = jnp.mean(xf, axis=-1, keepdims=True)
    xc = xf - mu
    y = xc * lax.rsqrt(jnp.mean(xc * xc, axis=-1, keepdims=True) + EPS)
    return (y * g.astype(jnp.float32) + b.astype(jnp.float32)).astype(x.dtype)


def causal_dwconv(x, hist, w):
    xx = jnp.concatenate([hist.astype(x.dtype), x], axis=1)
    y = lax.conv_general_dilated(xx, w.astype(x.dtype)[:, None, :], (1,), 'VALID',
                                 dimension_numbers=('NWC', 'WIO', 'NWC'),
                                 feature_group_count=x.shape[-1])
    return y, xx[:, -(w.shape[0] - 1):]


def chunk_spatial_mix(v, w_s, b_s):
    n, L, hb, dh = v.shape
    nc = -(-L // CHUNK)
    vp = jnp.pad(v, ((0, 0), (0, nc * CHUNK - L), (0, 0), (0, 0))).reshape(n, nc, CHUNK, hb, dh)
    causal = jnp.tril(jnp.ones((CHUNK, CHUNK), dtype=bool))
    w = jnp.where(causal[None], w_s, 0).astype(v.dtype)
    s = jnp.einsum('hts,ncshd->ncthd', w, vp) + b_s.T.astype(v.dtype)[None, None, :, :, None]
    return s.reshape(n, nc * CHUNK, hb, dh)[:, :L]


def mixer_layer(h, p_i, hist_a, hist_c, g_mix, w_in, conv_a_w, ln_b_g, ln_b_b, w_s, b_s,
                conv_c_w, conv_c_b, ln_c_g, ln_c_b, g_out_a, g_out_b, g_out_c, w_out,
                g_ffn, w_gate, w_up, w_down, g_ple, w_ple_gate, w_ple_proj):
    n, L, _ = h.shape
    z = rmsnorm(h, g_mix) @ w_in
    xa, gate_b, gate_c, u, v, c_in = jnp.split(z, SPLITS, axis=-1)
    conv_a, new_a = causal_dwconv(gate_c * xa, hist_a, conv_a_w)
    y_a = gate_b * conv_a
    u = jax.nn.gelu(u, approximate=False)
    v = layernorm(jax.nn.gelu(v, approximate=False), ln_b_g, ln_b_b)
    s = chunk_spatial_mix(v.reshape(n, L, N_HEADS_B, HEAD_DIM), w_s, b_s).reshape(n, L, D_B)
    y_b = u * s
    new_v = v[:, L - ((L - 1) % CHUNK + 1):]
    glu = c_in[..., :D_C] * jax.nn.sigmoid(c_in[..., D_C:])
    conv_c, new_c = causal_dwconv(glu, hist_c, conv_c_w)
    y_c = jax.nn.silu(layernorm(conv_c + conv_c_b.astype(h.dtype), ln_c_g, ln_c_b))
    mixed = jnp.concatenate([rmsnorm(y_a, g_out_a), rmsnorm(y_b, g_out_b), rmsnorm(y_c, g_out_c)], axis=-1)
    h = h + mixed @ w_out
    f = rmsnorm(h, g_ffn)
    h = h + (jax.nn.silu(f @ w_gate) * (f @ w_up)) @ w_down
    gate = jax.nn.sigmoid(rmsnorm(h, g_ple) @ w_ple_gate)
    h = h + gate * (p_i @ w_ple_proj)
    return h, new_a, new_c, new_v


def run_trunk(x, p, hist_a, hist_c, layer_weights, g_final):
    h = x
    sa, sc, sv = [], [], []
    for i in range(DEPTH):
        h, na, nc, nv = mixer_layer(h, p[i], hist_a[i], hist_c[i], *[w[i] for w in layer_weights])
        sa.append(na)
        sc.append(nc)
        sv.append(nv)
    return rmsnorm(h, g_final), jnp.stack(sa), jnp.stack(sc), jnp.stack(sv)


def setup_inputs(seed: int = 0) -> dict:
    key = jax.random.key(seed)
    ks = jax.random.split(key, 32)
    f32 = jnp.float32

    def nrm(k, shape, scale):
        return jax.random.normal(k, shape, f32) * scale

    def gain(k, shape):
        return 1.0 + 0.1 * jax.random.normal(k, shape, f32)

    return {
        'x_prompt': nrm(ks[0], (BATCH, SEQ, D_MODEL), 1.0),
        'x_sample': nrm(ks[1], (DEC_BATCH, DEC_SEQ, D_MODEL), 1.0),
        'state_conv_a': nrm(ks[2], (DEPTH, DEC_BATCH, CONV_A_WIDTH - 1, D_A), 0.5),
        'state_conv_c': nrm(ks[3], (DEPTH, DEC_BATCH, CONV_C_WIDTH - 1, D_C), 0.5),
        'p_prompt': nrm(ks[4], (DEPTH, BATCH, SEQ, D_PLE), 1.0),
        'p_sample': nrm(ks[5], (DEPTH, DEC_BATCH, DEC_SEQ, D_PLE), 1.0),
        'g_mix': gain(ks[6], (DEPTH, D_MODEL)),
        'w_in': nrm(ks[7], (DEPTH, D_MODEL, D_IN), D_MODEL ** -0.5),
        'conv_a_w': nrm(ks[8], (DEPTH, CONV_A_WIDTH, D_A), CONV_A_WIDTH ** -0.5),
        'ln_b_g': gain(ks[9], (DEPTH, D_B)),
        'ln_b_b': nrm(ks[10], (DEPTH, D_B), 0.02),
        'w_s': nrm(ks[11], (DEPTH, N_HEADS_B, CHUNK, CHUNK), CHUNK ** -0.5),
        'b_s': gain(ks[12], (DEPTH, N_HEADS_B, CHUNK)),
        'conv_c_w': nrm(ks[13], (DEPTH, CONV_C_WIDTH, D_C), CONV_C_WIDTH ** -0.5),
        'conv_c_b': nrm(ks[14], (DEPTH, D_C), 0.02),
        'ln_c_g': gain(ks[15], (DEPTH, D_C)),
        'ln_c_b': nrm(ks[16], (DEPTH, D_C), 0.02),
        'g_out_a': gain(ks[17], (DEPTH, D_A)),
        'g_out_b': gain(ks[18], (DEPTH, D_B)),
        'g_out_c': gain(ks[19], (DEPTH, D_C)),
        'w_out': nrm(ks[20], (DEPTH, D_MIX, D_MODEL), D_MIX ** -0.5),
        'g_ffn': gain(ks[21], (DEPTH, D_MODEL)),
        'w_gate': nrm(ks[22], (DEPTH, D_MODEL, D_FF), D_MODEL ** -0.5),
        'w_up': nrm(ks[23], (DEPTH, D_MODEL, D_FF), D_MODEL ** -0.5),
        'w_down': nrm(ks[24], (DEPTH, D_FF, D_MODEL), D_FF ** -0.5),
        'g_ple': gain(ks[25], (DEPTH, D_MODEL)),
        'w_ple_gate': nrm(ks[26], (DEPTH, D_MODEL, D_MODEL), D_MODEL ** -0.5),
        'w_ple_proj': nrm(ks[27], (DEPTH, D_PLE, D_MODEL), D_PLE ** -0.5),
        'g_final': gain(ks[28], (D_MODEL,)),
    }


def reference(x_prompt, x_sample, state_conv_a, state_conv_c, p_prompt, p_sample,
              g_mix, w_in, conv_a_w, ln_b_g, ln_b_b, w_s, b_s, conv_c_w, conv_c_b,
              ln_c_g, ln_c_b, g_out_a, g_out_b, g_out_c, w_out, g_ffn, w_gate, w_up,
              w_down, g_ple, w_ple_gate, w_ple_proj, g_final):
    layer_weights = (g_mix, w_in, conv_a_w, ln_b_g, ln_b_b, w_s, b_s, conv_c_w, conv_c_b,
                     ln_c_g, ln_c_b, g_out_a, g_out_b, g_out_c, w_out, g_ffn, w_gate, w_up,
                     w_down, g_ple, w_ple_gate, w_ple_proj)
    nb = x_prompt.shape[0]
    hist_a0 = jnp.zeros((DEPTH, nb, CONV_A_WIDTH - 1, D_A), x_prompt.dtype)
    hist_c0 = jnp.zeros((DEPTH, nb, CONV_C_WIDTH - 1, D_C), x_prompt.dtype)
    y_prompt, conv_a_p, conv_c_p, chunk_v_p = run_trunk(x_prompt, p_prompt, hist_a0, hist_c0,
                                                        layer_weights, g_final)
    y_sample, conv_a_s, conv_c_s, chunk_v_s = run_trunk(x_sample, p_sample, state_conv_a, state_conv_c,
                                                        layer_weights, g_final)
    return (y_prompt, y_sample, conv_a_p, conv_a_s, conv_c_p, conv_c_s, chunk_v_p, chunk_v_s)
```

```cpp
#include <hip/hip_runtime.h>
#include <cstdio>
#include <cstdint>
namespace pg8 {
#define PG8_LAS __attribute__((address_space(3)))
typedef unsigned short bf16_t;
typedef short bf16x8 __attribute__((ext_vector_type(8)));
typedef float f32x4 __attribute__((ext_vector_type(4)));
typedef unsigned u32x4 __attribute__((ext_vector_type(4)));
constexpr int BM = 256, BK = 64, HALF = 128, HTB = HALF * BK * 2  , STAGE_BYTES = 8 * HTB, NXCD = 8, WGM = 8;

__host__ __device__ __forceinline__ int lds_byte(int r, int c) { const int st = (r >> 4) * 2 + (c >> 5), rr = r & 15, cc = c & 31, ob = rr * 64 + cc * 2; return st * 1024 + (ob ^ (((ob >> 9) & 1) << 5)); }
__host__ __device__ __forceinline__ void stage_rc(int b, int& R, int& C) { const int st = b / 1024, sb = b % 1024, swz = sb ^ (((sb >> 9) & 1) << 5); R = (st >> 1) * 16 + swz / 64; C = (st & 1) * 32 + (swz % 64) / 2; }
__host__ __device__ __forceinline__ int perm32(int rho) { const int n = rho >> 4, i = rho & 15; return 8 * (i >> 2) + 4 * n + (i & 3); }

struct Unit { int pm, pn; };
struct Gemm { const bf16_t* A; const bf16_t* Bt; int M, N, K; };

struct StaticOrder {
    int nM, nN, nwg, G, c;
    __host__ __device__ void init(int M, int N, int G_, int c_) { nM = M / BM; nN = N / BM; nwg = nM * nN; G = G_; c = c_; }
    __host__ __device__ bool next(int i, Unit& u) const {
        const long L = (long)i * G + c; if (L >= nwg) return false;
        int wgid = (int)L; { const int q = nwg / NXCD, r = nwg % NXCD, xcd = wgid % NXCD, off = wgid / NXCD; wgid = (xcd < r ? xcd * (q + 1) : r * (q + 1) + (xcd - r) * q) + off; }
        const int nig = WGM * nN, gid = wgid / nig, fm = gid * WGM, gsz = (nM - fm) < WGM ? (nM - fm) : WGM;
        u.pm = fm + ((wgid % nig) % gsz); u.pn = (wgid % nig) / gsz; return true;
    }
    __device__ __forceinline__ void a_ready(const Unit&) const {}
    __device__ __forceinline__ void done(const Unit&) const {}
};

__device__ __forceinline__ unsigned cvt_pk_bf16(float lo, float hi) { unsigned r; asm volatile("v_cvt_pk_bf16_f32 %0, %1, %2" : "=v"(r) : "v"(lo), "v"(hi)); return r; }
typedef float f32x2 __attribute__((ext_vector_type(2)));
__device__ __forceinline__ f32x2 gelu_pk(f32x2 v) {
    const f32x2 av = __builtin_elementwise_abs(v), d = av * 0.2316418882f + 1.0f;
    f32x2 t; t.x = __builtin_amdgcn_rcpf(d.x); t.y = __builtin_amdgcn_rcpf(d.y);
    f32x2 q = t * 0.5307027145f + (-0.7265760135f); q = q * t + 0.7107068705f; q = q * t + (-0.142248368f); q = q * t + 0.127414796f; q = q * t;
    const f32x2 s = (v * v) * (-0.72134752044f);
    f32x2 e; e.x = __builtin_amdgcn_exp2f(s.x); e.y = __builtin_amdgcn_exp2f(s.y);
    const f32x2 m = v * (q * e), r = v - m;
    f32x2 o; o.x = v.x < 0.f ? m.x : r.x; o.y = v.y < 0.f ? m.y : r.y; return o;
}

constexpr int TP_ROWS = 16384;
constexpr float RMS_EPS = 1e-6f;
__device__ __forceinline__ float sigm(float x) { return __builtin_amdgcn_rcpf(1.0f + __builtin_amdgcn_exp2f(-1.44269504089f * x)); }
__device__ __forceinline__ f32x4 sigm4(f32x4 x) { return (f32x4){sigm(x[0]), sigm(x[1]), sigm(x[2]), sigm(x[3])}; }
__device__ __forceinline__ f32x4 gelu4(f32x4 x) { const f32x2 a = gelu_pk((f32x2){x[0], x[1]}), b = gelu_pk((f32x2){x[2], x[3]}); return (f32x4){a.x, a.y, b.x, b.y}; }
__device__ __forceinline__ void st_bf16x8(bf16_t* p, f32x4 v0, f32x4 v1) { u32x4 w; w.x = cvt_pk_bf16(v0[0], v0[1]); w.y = cvt_pk_bf16(v0[2], v0[3]); w.z = cvt_pk_bf16(v1[0], v1[1]); w.w = cvt_pk_bf16(v1[2], v1[3]); *(u32x4*)p = w; }
__device__ __forceinline__ float bf_lo(unsigned w) { return __uint_as_float(w << 16); }
__device__ __forceinline__ float bf_hi(unsigned w) { return __uint_as_float(w & 0xffff0000u); }
__device__ __forceinline__ float sumsq4(f32x4 v) { return (v[0] * v[0] + v[1] * v[1]) + (v[2] * v[2] + v[3] * v[3]); }
__device__ __forceinline__ float row_ss(const float* ssp, int row) { const f32x4* p = (const f32x4*)(ssp + (size_t)row * 16); const f32x4 a = p[0], b = p[1], c = p[2], d = p[3];
    return (((a[0] + a[1]) + (a[2] + a[3])) + ((b[0] + b[1]) + (b[2] + b[3]))) + (((c[0] + c[1]) + (c[2] + c[3])) + ((d[0] + d[1]) + (d[2] + d[3]))); }

struct EpiZ {
    static constexpr bool PERM = true, AFTER_DRAIN = false;
    bf16_t* Z; const float* ss; int zld;
    __device__ __forceinline__ void operator()(const f32x4 (&acc)[2][2][4][2], const Unit& u, int wr, int wc, int fr, int fq) const {
        const int row0 = u.pm * BM + wr * 64 + fr, cl = wc * 32 + 8 * fq, pn = u.pn;
#pragma unroll
        for (int ai = 0; ai < 2; ++ai)
#pragma unroll
            for (int m = 0; m < 4; ++m) {
                const int row = row0 + ai * HALF + m * 16; const float rs = rsqrtf(row_ss(ss, row) * (1.0f / 1024.0f) + RMS_EPS); bf16_t* zr = Z + (size_t)row * zld;
                if (pn < 3) { const f32x4 v0 = (acc[ai][0][m][0] * rs) * (acc[ai][1][m][0] * rs), v1 = (acc[ai][0][m][1] * rs) * (acc[ai][1][m][1] * rs); st_bf16x8(zr + 128 * pn + cl, v0, v1); }
                else if (pn < 5) { const f32x4 v0 = (acc[ai][0][m][0] * rs) * sigm4(acc[ai][1][m][0] * rs), v1 = (acc[ai][0][m][1] * rs) * sigm4(acc[ai][1][m][1] * rs); st_bf16x8(zr + 384 + 128 * (pn - 3) + cl, v0, v1); }
                else {
#pragma unroll
                    for (int bj = 0; bj < 2; ++bj) { const int kb = 2 * pn + bj; if (kb < 19) { f32x4 v0 = acc[ai][bj][m][0] * rs, v1 = acc[ai][bj][m][1] * rs; if (kb >= 13) { v0 = gelu4(v0); v1 = gelu4(v1); } st_bf16x8(zr + 640 + (kb - 10) * 128 + cl, v0, v1); } }
                }
            }
    }
};
struct EpiPlain {
    static constexpr bool PERM = true, AFTER_DRAIN = false;
    bf16_t* O; int ldc;
    __device__ __forceinline__ void operator()(const f32x4 (&acc)[2][2][4][2], const Unit& u, int wr, int wc, int fr, int fq) const {
        const int row0 = u.pm * BM + wr * 64 + fr, col0 = u.pn * BM + wc * 32 + 8 * fq;
#pragma unroll
        for (int ai = 0; ai < 2; ++ai)
#pragma unroll
            for (int m = 0; m < 4; ++m) { bf16_t* rowp = O + (size_t)(row0 + ai * HALF + m * 16) * ldc + col0;
#pragma unroll
                for (int bj = 0; bj < 2; ++bj) st_bf16x8(rowp + bj * HALF, acc[ai][bj][m][0], acc[ai][bj][m][1]); }
    }
};
struct EpiRes {
    static constexpr bool PERM = true, AFTER_DRAIN = false;
    const float* hin_p; const float* hin_s; float* hout; bf16_t* hb; float* ssq;
    __device__ __forceinline__ void operator()(const f32x4 (&acc)[2][2][4][2], const Unit& u, int wr, int wc, int fr, int fq) const {
        const int row0 = u.pm * BM + wr * 64 + fr, col0 = u.pn * BM + wc * 32 + 8 * fq;
        const bool isp = (u.pm * BM < TP_ROWS); const float* hin = isp ? hin_p : hin_s; const int rsub = isp ? 0 : TP_ROWS;
#pragma unroll
        for (int ai = 0; ai < 2; ++ai)
#pragma unroll
            for (int m = 0; m < 4; ++m) { const int row = row0 + ai * HALF + m * 16; const size_t off = (size_t)row * 1024 + col0, offi = (size_t)(row - rsub) * 1024 + col0; float q = 0.f;
#pragma unroll
                for (int bj = 0; bj < 2; ++bj) { const f32x4 a0 = *(const f32x4*)(hin + offi + bj * HALF), a1 = *(const f32x4*)(hin + offi + bj * HALF + 4);
                    const f32x4 v0 = a0 + acc[ai][bj][m][0], v1 = a1 + acc[ai][bj][m][1];
                    *(f32x4*)(hout + off + bj * HALF) = v0; *(f32x4*)(hout + off + bj * HALF + 4) = v1; st_bf16x8(hb + off + bj * HALF, v0, v1); q += sumsq4(v0) + sumsq4(v1); }
                q += __shfl_xor(q, 16); q += __shfl_xor(q, 32);
                if (fq == 0) ssq[(size_t)row * 16 + 4 * u.pn + wc] = q; }
    }
};
struct EpiGU {
    static constexpr bool PERM = true, AFTER_DRAIN = false;
    bf16_t* O; const float* ss; int ldc;
    __device__ __forceinline__ void operator()(const f32x4 (&acc)[2][2][4][2], const Unit& u, int wr, int wc, int fr, int fq) const {
        const int row0 = u.pm * BM + wr * 64 + fr, col0 = u.pn * HALF + wc * 32 + 8 * fq;
#pragma unroll
        for (int ai = 0; ai < 2; ++ai)
#pragma unroll
            for (int m = 0; m < 4; ++m) { const int row = row0 + ai * HALF + m * 16; const float rs = rsqrtf(row_ss(ss, row) * (1.0f / 1024.0f) + RMS_EPS);
                const f32x4 g0 = acc[ai][0][m][0] * rs, g1 = acc[ai][0][m][1] * rs, u0 = acc[ai][1][m][0] * rs, u1 = acc[ai][1][m][1] * rs;
                st_bf16x8(O + (size_t)row * ldc + col0, g0 * sigm4(g0) * u0, g1 * sigm4(g1) * u1); }
    }
};
struct EpiPle {
    static constexpr bool PERM = true, AFTER_DRAIN = false;
    float* h; bf16_t* hb; const bf16_t* proj; const float* ss; float* ssq;
    __device__ __forceinline__ void operator()(const f32x4 (&acc)[2][2][4][2], const Unit& u, int wr, int wc, int fr, int fq) const {
        const int row0 = u.pm * BM + wr * 64 + fr, col0 = u.pn * BM + wc * 32 + 8 * fq;
#pragma unroll
        for (int ai = 0; ai < 2; ++ai)
#pragma unroll
            for (int m = 0; m < 4; ++m) { const int row = row0 + ai * HALF + m * 16; const size_t off = (size_t)row * 1024 + col0; float q = 0.f;
                const float rs = rsqrtf(row_ss(ss, row) * (1.0f / 1024.0f) + RMS_EPS);
#pragma unroll
                for (int bj = 0; bj < 2; ++bj) { const f32x4 a0 = *(const f32x4*)(h + off + bj * HALF), a1 = *(const f32x4*)(h + off + bj * HALF + 4);
                    const u32x4 pw = *(const u32x4*)(proj + off + bj * HALF);
                    const f32x4 p0 = (f32x4){bf_lo(pw.x), bf_hi(pw.x), bf_lo(pw.y), bf_hi(pw.y)}, p1 = (f32x4){bf_lo(pw.z), bf_hi(pw.z), bf_lo(pw.w), bf_hi(pw.w)};
                    const f32x4 v0 = a0 + sigm4(acc[ai][bj][m][0] * rs) * p0, v1 = a1 + sigm4(acc[ai][bj][m][1] * rs) * p1;
                    *(f32x4*)(h + off + bj * HALF) = v0; *(f32x4*)(h + off + bj * HALF + 4) = v1; st_bf16x8(hb + off + bj * HALF, v0, v1); q += sumsq4(v0) + sumsq4(v1); }
                q += __shfl_xor(q, 16); q += __shfl_xor(q, 32);
                if (fq == 0) ssq[(size_t)row * 16 + 4 * u.pn + wc] = q; }
    }
};
template <class Epi, class Sched, bool ALIGN_EPI = false, bool SP2 = false>
__device__ __forceinline__ void gemm_phase(PG8_LAS unsigned char* lds, const Gemm g, const Sched& S, const Epi& E) {
    int tid_ = threadIdx.x; asm volatile("" : "+v"(tid_));
    const int tid = tid_, wid = __builtin_amdgcn_readfirstlane(tid >> 6), lane = tid & 63, wr = wid >> 2, wc = wid & 3, fr = lane & 15, fq = lane >> 4;
    int K_ = g.K; asm volatile("" : "+s"(K_));
    const int K = K_, nt = K / BK;
    unsigned voffA[2], voffB[2];
#pragma unroll
    for (int i = 0; i < 2; ++i) { int R, C; stage_rc(tid * 16 + i * 8192, R, C); const int Rb = Epi::PERM ? ((R & ~31) + perm32(R & 31)) : R;
        voffA[i] = (unsigned)(R * K + C) * 2u; voffB[i] = (unsigned)(Rb * K + C) * 2u; }
    const size_t kstep = (size_t)(BK * 2);
    const size_t hstep = (size_t)HALF * K * 2;
    const size_t tstep = 2 * hstep;
    const unsigned ldsw = (unsigned)wid * 1024u;
    const int aoff = lds_byte(wr * 64 + fr, fq * 8), boff = lds_byte(wc * 32 + fr, fq * 8);
#define PG8_SA(b, h) (((b) * 2 + (h)) * HTB)
#define PG8_SB(b, h) ((4 + (b) * 2 + (h)) * HTB)
#define PG8_STAGE(bufoff, gbase, voff) do { _Pragma("unroll") for (int _i = 0; _i < 2; ++_i) \
        __builtin_amdgcn_global_load_lds((const unsigned*)((const char*)(gbase) + (voff)[_i]), (PG8_LAS unsigned*)(lds + (bufoff) + ldsw + _i * 8192), 16, 0, 0); } while (0)
#define PG8_LDA(dst, b, h) do { _Pragma("unroll") for (int m = 0; m < 4; ++m) _Pragma("unroll") for (int k = 0; k < 2; ++k) dst[m][k] = *(const PG8_LAS bf16x8*)(lds + PG8_SA(b, h) + aoff + m * 2048 + k * 1024); } while (0)
#define PG8_LDB(dst, b, h) do { _Pragma("unroll") for (int n = 0; n < 2; ++n) _Pragma("unroll") for (int k = 0; k < 2; ++k) dst[n][k] = *(const PG8_LAS bf16x8*)(lds + PG8_SB(b, h) + boff + n * 2048 + k * 1024); } while (0)
#define PG8_MMA(ai, bj, At, Bt) do { __builtin_amdgcn_s_setprio(1); _Pragma("unroll") for (int m = 0; m < 4; ++m) _Pragma("unroll") for (int n = 0; n < 2; ++n) _Pragma("unroll") for (int k = 0; k < 2; ++k) \
        acc[ai][bj][m][n] = __builtin_amdgcn_mfma_f32_16x16x32_bf16(Bt[n][k], At[m][k], acc[ai][bj][m][n], 0, 0, 0); __builtin_amdgcn_s_setprio(0); } while (0)
#define PG8_WAIT_V(n) asm volatile("s_waitcnt vmcnt(" #n ")" ::: "memory")
#define PG8_WAIT_L(n) asm volatile("s_waitcnt lgkmcnt(" #n ")" ::: "memory")
#define PG8_BAR __builtin_amdgcn_s_barrier()
#define PG8_SCHED __builtin_amdgcn_sched_barrier(0)
    Unit cur, nxt; int ui = 0;
    if (!S.next(0, cur)) return;
    f32x4 acc[2][2][4][2];
#pragma unroll
    for (int a = 0; a < 2; ++a)
#pragma unroll
        for (int b = 0; b < 2; ++b)
#pragma unroll
            for (int m = 0; m < 4; ++m)
#pragma unroll
                for (int n = 0; n < 2; ++n) acc[a][b][m][n] = (f32x4){0.f, 0.f, 0.f, 0.f};
    bf16x8 At[4][2], B0[2][2], B1[2][2];
    const char* cA = (const char*)g.A + (size_t)cur.pm * tstep; const char* cB = (const char*)g.Bt + (size_t)cur.pn * tstep;
    S.a_ready(cur);
    if constexpr (SP2) {
        PG8_STAGE(PG8_SB(0, 0), cB, voffB); PG8_STAGE(PG8_SB(0, 1), cB + hstep, voffB); PG8_STAGE(PG8_SA(0, 0), cA, voffA); PG8_STAGE(PG8_SA(0, 1), cA + hstep, voffA);
        if (wr == 1) PG8_BAR;
        PG8_WAIT_V(2); PG8_BAR;
        PG8_STAGE(PG8_SB(1, 0), cB + kstep, voffB); PG8_STAGE(PG8_SA(1, 0), cA + kstep, voffA); PG8_STAGE(PG8_SB(1, 1), cB + hstep + kstep, voffB);
        PG8_WAIT_V(6); PG8_BAR;
    } else {
        PG8_STAGE(PG8_SB(0, 0), cB, voffB); PG8_STAGE(PG8_SA(0, 0), cA, voffA); PG8_STAGE(PG8_SB(0, 1), cB + hstep, voffB); PG8_STAGE(PG8_SA(0, 1), cA + hstep, voffA);
        if (wr == 1) PG8_BAR;
        PG8_WAIT_V(4); PG8_BAR;
        PG8_STAGE(PG8_SB(1, 0), cB + kstep, voffB); PG8_STAGE(PG8_SA(1, 0), cA + kstep, voffA); PG8_STAGE(PG8_SB(1, 1), cB + hstep + kstep, voffB);
        PG8_WAIT_V(6); PG8_BAR;
    }
    for (;;) {
        const bool has_next = S.next(ui + 1, nxt);
        const char* nA = has_next ? (const char*)g.A + (size_t)nxt.pm * tstep : cA; const char* nB = has_next ? (const char*)g.Bt + (size_t)nxt.pn * tstep : cB;
        for (int t = 0; t < nt; t += 2) {
            const bool last = (t == nt - 2);
            const char* a1 = cA + (size_t)(t + 1) * kstep;
            const char* a2 = last ? nA : cA + (size_t)(t + 2) * kstep; const char* b2 = last ? nB : cB + (size_t)(t + 2) * kstep;
            const char* a3 = a2 + kstep; const char* b3 = b2 + kstep;
            if (last && has_next) S.a_ready(nxt);
            if constexpr (SP2) {
            PG8_LDB(B0, 0, 0); PG8_LDB(B1, 0, 1); PG8_SCHED; PG8_LDA(At, 0, 0); PG8_STAGE(PG8_SA(1, 1), a1 + hstep, voffA);
            PG8_WAIT_V(8); PG8_WAIT_L(0); PG8_BAR; PG8_MMA(0, 0, At, B0); PG8_MMA(0, 1, At, B1); PG8_BAR; PG8_SCHED;
            PG8_LDA(At, 0, 1); PG8_STAGE(PG8_SB(0, 0), b2, voffB); PG8_STAGE(PG8_SB(0, 1), b2 + hstep, voffB); PG8_STAGE(PG8_SA(0, 0), a2, voffA);
            PG8_WAIT_V(8); PG8_WAIT_L(0); PG8_BAR; PG8_MMA(1, 0, At, B0); PG8_MMA(1, 1, At, B1); PG8_BAR; PG8_SCHED;
            PG8_LDB(B0, 1, 0); PG8_LDB(B1, 1, 1); PG8_SCHED; PG8_LDA(At, 1, 0); PG8_STAGE(PG8_SA(0, 1), a2 + hstep, voffA);
            PG8_WAIT_V(8); PG8_WAIT_L(0); PG8_BAR; PG8_MMA(0, 0, At, B0); PG8_MMA(0, 1, At, B1); PG8_BAR; PG8_SCHED;
            PG8_LDA(At, 1, 1); PG8_STAGE(PG8_SB(1, 0), b3, voffB); PG8_STAGE(PG8_SB(1, 1), b3 + hstep, voffB); PG8_STAGE(PG8_SA(1, 0), a3, voffA);
            PG8_WAIT_V(8); PG8_WAIT_L(0); PG8_BAR; PG8_MMA(1, 0, At, B0); PG8_MMA(1, 1, At, B1); PG8_BAR; PG8_SCHED;
            } else {
            PG8_LDB(B0, 0, 0); PG8_SCHED; PG8_LDA(At, 0, 0); PG8_STAGE(PG8_SA(1, 1), a1 + hstep, voffA);
            PG8_WAIT_L(8); PG8_BAR; PG8_WAIT_L(0); PG8_MMA(0, 0, At, B0); PG8_BAR; PG8_SCHED;
            PG8_LDB(B1, 0, 1); PG8_STAGE(PG8_SB(0, 0), b2, voffB);
            PG8_BAR; PG8_WAIT_L(0); PG8_MMA(0, 1, At, B1); PG8_BAR;
            PG8_LDA(At, 0, 1); PG8_STAGE(PG8_SA(0, 0), a2, voffA);
            PG8_BAR; PG8_WAIT_L(0); PG8_MMA(1, 0, At, B0); PG8_BAR; PG8_SCHED;
            PG8_STAGE(PG8_SB(0, 1), b2 + hstep, voffB);
            PG8_WAIT_V(6); PG8_BAR; PG8_MMA(1, 1, At, B1); PG8_BAR;
            PG8_LDB(B0, 1, 0); PG8_SCHED; PG8_LDA(At, 1, 0); PG8_STAGE(PG8_SA(0, 1), a2 + hstep, voffA);
            PG8_WAIT_L(8); PG8_BAR; PG8_WAIT_L(0); PG8_MMA(0, 0, At, B0); PG8_BAR; PG8_SCHED;
            PG8_LDB(B1, 1, 1); PG8_STAGE(PG8_SB(1, 0), b3, voffB);
            PG8_BAR; PG8_WAIT_L(0); PG8_MMA(0, 1, At, B1); PG8_BAR;
            PG8_LDA(At, 1, 1); PG8_STAGE(PG8_SA(1, 0), a3, voffA);
            PG8_BAR; PG8_WAIT_L(0); PG8_MMA(1, 0, At, B0); PG8_BAR; PG8_SCHED;
            PG8_STAGE(PG8_SB(1, 1), b3 + hstep, voffB);
            PG8_WAIT_V(6); PG8_BAR; PG8_MMA(1, 1, At, B1); PG8_BAR;
            }
        }
        if constexpr (ALIGN_EPI) { if (wr == 0) PG8_BAR; }
        if constexpr (!Epi::AFTER_DRAIN) { E(acc, cur, wr, wc, fr, fq); S.done(cur); }
        if (!has_next) break;
#pragma unroll
        for (int a = 0; a < 2; ++a)
#pragma unroll
            for (int b = 0; b < 2; ++b)
#pragma unroll
                for (int m = 0; m < 4; ++m)
#pragma unroll
                    for (int n = 0; n < 2; ++n) acc[a][b][m][n] = (f32x4){0.f, 0.f, 0.f, 0.f};
        cur = nxt; cA = nA; cB = nB; ++ui;
        if constexpr (ALIGN_EPI) { if (wr == 1) PG8_BAR; }
    }
    PG8_WAIT_V(0);
    if constexpr (!ALIGN_EPI) { if (wr == 0) PG8_BAR; }
    PG8_BAR;
    if constexpr (Epi::AFTER_DRAIN) { E.fused(acc, cur, wr, wc, fr, fq, lds, wid, lane); S.done(cur); }
#undef PG8_SA
#undef PG8_SB
#undef PG8_STAGE
#undef PG8_LDA
#undef PG8_LDB
#undef PG8_MMA
#undef PG8_WAIT_V
#undef PG8_WAIT_L
#undef PG8_BAR
#undef PG8_SCHED
}
}
#define GAS __attribute__((address_space(1)))
#define LAS __attribute__((address_space(3)))
typedef unsigned short bf16;
typedef unsigned v4u __attribute__((ext_vector_type(4)));
typedef float f32x4 __attribute__((ext_vector_type(4)));
typedef short bf16x8 __attribute__((ext_vector_type(8)));
typedef GAS unsigned gu32;
typedef GAS unsigned long long gu64;
#define RLX_AGENT __ATOMIC_RELAXED, __HIP_MEMORY_SCOPE_AGENT
#define LDS_WAIT() asm volatile("s_waitcnt lgkmcnt(0)" ::: "memory")
#define VM_WAIT() asm volatile("s_waitcnt vmcnt(0)" ::: "memory")
__device__ __forceinline__ unsigned long long rt() { return __builtin_amdgcn_s_memrealtime(); }
__device__ __forceinline__ unsigned f2bf(float f) { unsigned u = __builtin_bit_cast(unsigned, f); return (u + 0x7fffu + ((u >> 16) & 1u)) >> 16; }
__device__ __forceinline__ unsigned pk2(float lo, float hi) { return f2bf(lo) | (f2bf(hi) << 16); }

#define XB_TMO      128
#define XB_XCNT(j)  (256  + 64 * (j))
#define XB_XSUB(j)  (1280 + 64 * (j))
#define XB_XGEN(j)  (2304 + 64 * (j))
#define XB_TOP      3328
#define XB_TOPGEN   3392
#define XCD_BAR_WORDS 3456
#define XB_SPIN_CAP (1u << 18)

__device__ __forceinline__ unsigned xb_ld(unsigned* p)              { return __hip_atomic_load(p, __ATOMIC_RELAXED, __HIP_MEMORY_SCOPE_AGENT); }
__device__ __forceinline__ unsigned xb_add(unsigned* p, unsigned v) { return __hip_atomic_fetch_add(p, v, __ATOMIC_RELAXED, __HIP_MEMORY_SCOPE_AGENT); }
__device__ __forceinline__ unsigned xb_xcc_id() { return (unsigned)__builtin_amdgcn_s_getreg((3 << 11) | 20) & 0xFu; }
#define XB_SPIN(cond, bar) do { unsigned _sp = 0; while (cond) { __builtin_amdgcn_s_sleep(1); \
    if ((++_sp & 255u) == 0u) { if (xb_ld(&(bar)[XB_TMO])) break; if (_sp > XB_SPIN_CAP) { atomicAdd(&(bar)[XB_TMO], 1u); break; } } } } while (0)

struct XcdBarrier {
    unsigned* bar; unsigned x;
    volatile LAS unsigned* st;
};

__device__ __forceinline__ XcdBarrier xcd_barrier_post(unsigned* bar, volatile LAS unsigned* st) {
    XcdBarrier b; b.bar = bar; b.x = xb_xcc_id(); b.st = st;
    if (threadIdx.x == 0) (void)xb_add(&bar[XB_XCNT(b.x)], 1u);
    return b;
}
__device__ __forceinline__ void xcd_barrier_complete(unsigned* bar, unsigned x, unsigned& nloc, unsigned& nx) {
    const unsigned G = gridDim.x * gridDim.y * gridDim.z;
    unsigned sum, cnt, mine, sp = 0u;
    for (;;) {
        sum = 0u; cnt = 0u; mine = 0u;
#pragma unroll
        for (unsigned j = 0; j < 16; ++j) { const unsigned c = xb_ld(&bar[XB_XCNT(j)]); sum += c; cnt += (c > 0u) ? 1u : 0u; mine = (j == x) ? c : mine; }
        if (sum == G) break;
        __builtin_amdgcn_s_sleep(1);
        if ((++sp & 255u) == 0u) { if (xb_ld(&bar[XB_TMO])) break; if (sp > XB_SPIN_CAP) { atomicAdd(&bar[XB_TMO], 1u); break; } }
    }
    nloc = mine > 0u ? mine : 1u; nx = cnt > 0u ? cnt : 1u;
}

__device__ __forceinline__ void xcd_barrier(const XcdBarrier& b) {
    asm volatile("s_waitcnt vmcnt(0)" ::: "memory");
    __syncthreads();
    if (threadIdx.x == 0) {
        unsigned* bar = b.bar;
        __builtin_amdgcn_s_waitcnt(0);
        unsigned nloc = b.st[0], nx = b.st[1];
        if (nloc == 0u) { xcd_barrier_complete(bar, b.x, nloc, nx); b.st[0] = nloc; b.st[1] = nx; }
        const unsigned old = xb_add(&bar[XB_XSUB(b.x)], 1u);
        const unsigned gen = old / nloc;
        if (old + 1u == (gen + 1u) * nloc) {
            __builtin_amdgcn_fence(__ATOMIC_RELEASE, "agent");
            asm volatile("s_waitcnt vmcnt(0)" ::: "memory");
            const unsigned og = xb_add(&bar[XB_TOP], 1u);
            const unsigned tg = og / nx;
            if (og + 1u == (tg + 1u) * nx) xb_add(&bar[XB_TOPGEN], 1u);
            else XB_SPIN(xb_ld(&bar[XB_TOPGEN]) == tg, bar);
            __builtin_amdgcn_fence(__ATOMIC_ACQUIRE, "agent");
            xb_add(&bar[XB_XGEN(b.x)], 1u);
            asm volatile("s_waitcnt vmcnt(0)" ::: "memory");
        } else {
            XB_SPIN(xb_ld(&bar[XB_XGEN(b.x)]) == gen, bar);
            __builtin_amdgcn_fence(__ATOMIC_ACQUIRE, "agent");
            asm volatile("s_waitcnt vmcnt(0)" ::: "memory");
        }
    }
    __syncthreads();
}

constexpr int NWAVES = 8;
#ifndef MK_N_LAUNCHES
#define MK_N_LAUNCHES 26
#endif
constexpr int N_PHASES = 26;
constexpr int N_LAUNCHES = MK_N_LAUNCHES;

constexpr int TP = 16384, TS = 1024, TT = TP + TS;
constexpr int DM = 1024, DA = 384, DB = 384, DC = 256, DFF = 2816, DPLE = 256, NL = 4, DIN = 2432;
constexpr int ZN = 2560, ZLD = 1792;
constexpr int Z_CA = 0, Z_GLU = 384, Z_GB = 640, Z_U = 1024, Z_V = 1408;
constexpr int GUN = 2 * DFF;
constexpr float EPS = 1e-6f;
constexpr size_t O_Y = 0, O_NAP = 17825792, O_NAS = 17850368, O_NCP = 18243584, O_NCS = 18489344, O_NVP = 22421504, O_NVS = 23994368, O_END = 25567232;
constexpr size_t MiB = 1u << 20;
constexpr size_t WS_CTL = 0, CTL_ZERO_BYTES = 1 * MiB;
constexpr size_t WS_SS = 345 * MiB, SS_STRIDE = (size_t)17408 * 16;
constexpr size_t WS_WIN = 2 * MiB, WS_WOUT = 22 * MiB, WS_WGU = 30 * MiB, WS_WDN = 74 * MiB, WS_WPG = 96 * MiB, WS_WPP = 104 * MiB;
constexpr size_t WS_HB0 = 106 * MiB, WS_HB1 = 140 * MiB, WS_MIX = 174 * MiB, WS_PROJ = 208 * MiB, WS_PB = 242 * MiB, WS_ZACT = 251 * MiB, WS_END = 349 * MiB;
static_assert(3 * SS_STRIDE * 4 <= 4 * MiB && (size_t)NL * ZN * DM * 2 == 20 * MiB && (size_t)NL * GUN * DM * 2 == 44 * MiB && (size_t)TT * DM * 2 == 34 * MiB && (size_t)TT * DFF * 2 <= 94 * MiB && (size_t)TT * DPLE * 2 <= 9 * MiB, "d_ws map");
constexpr int CW_TMO = 0, CW_CODE = 1, CW_BAR = 4096;

constexpr int RING_OFF = 0, RING_BYTES = 131072;
constexpr int LDSCTL_OFF = RING_BYTES, MISC_OFF = LDSCTL_OFF + 320;
constexpr int LDS_BYTES = 147456;

struct Args { const float* in[29]; float* out; unsigned char* ws; int ph_lo, ph_hi; };
typedef unsigned u32x2 __attribute__((ext_vector_type(2)));
typedef short v4i16_t __attribute__((ext_vector_type(4)));

struct Frame {
    LAS unsigned char* lds;
    volatile LAS unsigned* MISC;
    gu32* ctl;
    int tid, lane, wave, G;
    float* out; unsigned char* ws;
};

__device__ __forceinline__ float wave_sum(float v) {
#pragma unroll
    for (int o = 1; o < 64; o <<= 1) v += __shfl_xor(v, o);
    return v;
}
__device__ __forceinline__ unsigned pk_bf16(float lo, float hi) { return pg8::cvt_pk_bf16(lo, hi); }
__device__ __forceinline__ f32x4 up4(u32x2 w) { return (f32x4){pg8::bf_lo(w.x), pg8::bf_hi(w.x), pg8::bf_lo(w.y), pg8::bf_hi(w.y)}; }
__device__ __forceinline__ u32x2 pk4(f32x4 v) { u32x2 w; w.x = pk_bf16(v[0], v[1]); w.y = pk_bf16(v[2], v[3]); return w; }

__device__ __forceinline__ void p0_transpose_item(const float* W, int K, int N, bf16* WT, int dst_row0, const float* gain, LAS float* scr, int k0, int n0, int lane) {
#pragma unroll 8
    for (int i = 0; i < 32; ++i) { const int kk = 2 * i + (lane >> 5); float w = W[(size_t)(k0 + kk) * N + n0 + (lane & 31)]; if (gain) w *= gain[k0 + kk]; scr[kk * 33 + (lane & 31)] = w; }
    LDS_WAIT(); asm volatile("" ::: "memory");
    const int c = lane & 7;
#pragma unroll
    for (int j = 0; j < 4; ++j) { const int n = (lane >> 3) + 8 * j; const LAS float* s = scr + (8 * c) * 33 + n;
        v4u o; o.x = pk_bf16(s[0 * 33], s[1 * 33]); o.y = pk_bf16(s[2 * 33], s[3 * 33]); o.z = pk_bf16(s[4 * 33], s[5 * 33]); o.w = pk_bf16(s[6 * 33], s[7 * 33]);
        *(GAS v4u*)(WT + (size_t)(dst_row0 + n) * K + k0 + 8 * c) = o; }
    LDS_WAIT(); asm volatile("" ::: "memory");
}
__device__ __forceinline__ void convert_p(const Frame& F, const Args& A, int l, int gw, int ngw) {
    bf16* PB = (bf16*)(F.ws + WS_PB);
    for (int r = gw; r < TT; r += ngw) {
        const float* src = (r < TP) ? A.in[4] + ((size_t)l * TP + r) * DPLE : A.in[5] + ((size_t)l * TS + (r - TP)) * DPLE;
        const f32x4 v = *(const f32x4*)(src + 4 * F.lane);
        *(u32x2*)(PB + (size_t)r * DPLE + 4 * F.lane) = pk4(v);
    }
}
__device__ __forceinline__ void p0_prologue(const Frame& F, const Args& A) {
    LAS float* scr = (LAS float*)(F.lds + RING_OFF + F.wave * 16384);
    const int gw = blockIdx.x * NWAVES + F.wave, NGW = F.G * NWAVES;
    constexpr int I_IN = 16 * 76, I_OUT = 16 * 32, I_G = 16 * 88, I_DN = 44 * 32, I_PG = 16 * 32, I_PP = 4 * 32;
    constexpr int I_LAYER = I_IN + I_OUT + 2 * I_G + I_DN + I_PG + I_PP;
    for (int it = gw; it < NL * I_LAYER; it += NGW) {
        const int l = it / I_LAYER; int r = it % I_LAYER;
        if (r < I_IN) { const int kb = r / 76, nb = r % 76, n0 = 32 * nb, sb = n0 >> 7;
            const int kd = sb < 3 ? 2 * sb : sb < 6 ? sb + 7 : sb < 9 ? 2 * sb - 11 : sb < 15 ? sb + 4 : sb < 17 ? 2 * sb - 24 : 2 * sb - 27;
            p0_transpose_item(A.in[7] + (size_t)l * DM * DIN, DM, DIN, (bf16*)(F.ws + WS_WIN) + (size_t)l * ZN * DM, kd * 128 + (n0 & 127), A.in[6] + l * DM, scr, 64 * kb, n0, F.lane); continue; } r -= I_IN;
        if (r < I_OUT) { const int kb = r / 32, nb = r % 32, k0 = 64 * kb;
            const float* g = k0 < DA ? A.in[17] + l * DA : k0 < DA + DB ? A.in[18] + l * DB - DA : A.in[19] + l * DC - (DA + DB);
            p0_transpose_item(A.in[20] + (size_t)l * DM * DM, DM, DM, (bf16*)(F.ws + WS_WOUT) + (size_t)l * DM * DM, 32 * nb, g, scr, k0, 32 * nb, F.lane); continue; } r -= I_OUT;
        if (r < 2 * I_G) { const int up = r >= I_G; if (up) r -= I_G; const int kb = r / 88, nb = r % 88, n0 = 32 * nb;
            p0_transpose_item((up ? A.in[23] : A.in[22]) + (size_t)l * DM * DFF, DM, DFF, (bf16*)(F.ws + WS_WGU) + (size_t)l * GUN * DM, (n0 >> 7) * 256 + up * 128 + (n0 & 127), A.in[21] + l * DM, scr, 64 * kb, n0, F.lane); continue; } r -= 2 * I_G;
        if (r < I_DN) { const int kb = r / 32, nb = r % 32;
            p0_transpose_item(A.in[24] + (size_t)l * DFF * DM, DFF, DM, (bf16*)(F.ws + WS_WDN) + (size_t)l * DM * DFF, 32 * nb, nullptr, scr, 64 * kb, 32 * nb, F.lane); continue; } r -= I_DN;
        if (r < I_PG) { const int kb = r / 32, nb = r % 32;
            p0_transpose_item(A.in[26] + (size_t)l * DM * DM, DM, DM, (bf16*)(F.ws + WS_WPG) + (size_t)l * DM * DM, 32 * nb, A.in[25] + l * DM, scr, 64 * kb, 32 * nb, F.lane); continue; } r -= I_PG;
        { const int kb = r / 32, nb = r % 32;
            p0_transpose_item(A.in[27] + (size_t)l * DPLE * DM, DPLE, DM, (bf16*)(F.ws + WS_WPP) + (size_t)l * DM * DPLE, 32 * nb, nullptr, scr, 64 * kb, 32 * nb, F.lane); }
    }
    bf16* HB0 = (bf16*)(F.ws + WS_HB0); float* ss0 = (float*)(F.ws + WS_SS);
    for (int m = gw; m < TT; m += NGW) {
        const float* xr = (m < TP) ? A.in[0] + (size_t)m * DM : A.in[1] + (size_t)(m - TP) * DM;
        float s = 0.f;
#pragma unroll
        for (int j = 0; j < 4; ++j) { const f32x4 v = *(const f32x4*)(xr + 256 * j + 4 * F.lane); s += pg8::sumsq4(v); *(u32x2*)(HB0 + (size_t)m * DM + 256 * j + 4 * F.lane) = pk4(v); }
        s = wave_sum(s); if (F.lane < 16) ss0[(size_t)m * 16 + F.lane] = (F.lane == 0) ? s : 0.f;
    }
    convert_p(F, A, 0, gw, NGW);
}

__device__ __forceinline__ void mix_a(const Frame& F, const Args& A, int l, int c) {
    const bf16* ZB = (const bf16*)(F.ws + WS_ZACT); bf16* MIX = (bf16*)(F.ws + WS_MIX);
    int tid_ = F.tid; asm volatile("" : "+v"(tid_)); const int hw = tid_ >> 5, l32 = tid_ & 31; const int r0 = 128 * c + 8 * hw; const bool samp = (c >= 128);
    const float* cw = A.in[8] + (size_t)l * 3 * DA;
    f32x4 w0[3], w1[3], w2[3], p2[3], p1[3];
    const int q = samp ? (r0 - TP) >> 3 : 0;
#pragma unroll
    for (int i = 0; i < 3; ++i) { const int col = 4 * (l32 + 32 * i);
        w0[i] = *(const f32x4*)(cw + col); w1[i] = *(const f32x4*)(cw + DA + col); w2[i] = *(const f32x4*)(cw + 2 * DA + col);
        if (samp) { const float* st = A.in[2] + ((size_t)(l * 128 + q) * 2) * DA; p2[i] = *(const f32x4*)(st + col); p1[i] = *(const f32x4*)(st + DA + col); }
        else if (((c & 15) == 0) && hw == 0) { p2[i] = (f32x4){0.f, 0.f, 0.f, 0.f}; p1[i] = p2[i]; }
        else { p2[i] = up4(*(const u32x2*)(ZB + (size_t)(r0 - 2) * ZLD + Z_CA + col)); p1[i] = up4(*(const u32x2*)(ZB + (size_t)(r0 - 1) * ZLD + Z_CA + col)); } }
#pragma unroll 1
    for (int rr = 0; rr < 8; ++rr) { const int row = r0 + rr; f32x4 cur[3], y[3]; float s = 0.f;
#pragma unroll
        for (int i = 0; i < 3; ++i) { const int col = 4 * (l32 + 32 * i);
            cur[i] = up4(*(const u32x2*)(ZB + (size_t)row * ZLD + Z_CA + col)); const f32x4 gb = up4(*(const u32x2*)(ZB + (size_t)row * ZLD + Z_GB + col));
            y[i] = gb * (w0[i] * p2[i] + w1[i] * p1[i] + w2[i] * cur[i]); s += pg8::sumsq4(y[i]); }
#pragma unroll
        for (int o = 1; o < 32; o <<= 1) s += __shfl_xor(s, o);
        const float rs = rsqrtf(s * (1.0f / DA) + EPS);
#pragma unroll
        for (int i = 0; i < 3; ++i) { const int col = 4 * (l32 + 32 * i);
            *(u32x2*)(MIX + (size_t)row * DM + col) = pk4(y[i] * rs);
            if (rr >= 6) { if (samp) *(f32x4*)(F.out + O_NAS + ((size_t)(l * 128 + q) * 2 + (rr - 6)) * DA + col) = cur[i];
                           else if ((c & 15) == 15 && hw == 15) *(f32x4*)(F.out + O_NAP + ((size_t)(l * 8 + (c >> 4)) * 2 + (rr - 6)) * DA + col) = cur[i]; }
            p2[i] = p1[i]; p1[i] = cur[i]; }
    }
}
__device__ __forceinline__ void mix_c(const Frame& F, const Args& A, int l, int c) {
    const bf16* ZB = (const bf16*)(F.ws + WS_ZACT); bf16* MIX = (bf16*)(F.ws + WS_MIX);
    int lane_ = F.lane; asm volatile("" : "+v"(lane_));
    const bool samp = (c >= 128); const int col = 4 * lane_;
    const float* cw = A.in[13] + (size_t)l * 31 * DC + col;
    const f32x4 bias = *(const f32x4*)(A.in[14] + l * DC + col), lg = *(const f32x4*)(A.in[15] + l * DC + col), lb = *(const f32x4*)(A.in[16] + l * DC + col);
    const f32x4 zero4 = (f32x4){0.f, 0.f, 0.f, 0.f};
#pragma unroll 1
    for (int hb = 0; hb < 2; ++hb) {
        const int rb = 16 * F.wave + 8 * hb;
        const int q = samp ? 16 * (c - 128) + 2 * F.wave + hb : 0;
        const float* st = A.in[3] + ((size_t)(l * 128 + q) * 30) * DC + col;
        const bf16* zb = ZB + ((size_t)128 * c + rb) * ZLD + Z_GLU + col;
        const int t0 = 128 * (c & 15) + rb - 30;
        f32x4 acc[8];
#pragma unroll
        for (int o = 0; o < 8; ++o) acc[o] = zero4;
#pragma unroll 1
        for (int kb = 0; kb < 4; ++kb) {
            f32x4 xw[15];
#pragma unroll
            for (int j = 0; j < 15; ++j) { const int i = 8 * kb + j; f32x4 xi = zero4;
                if (i <= 37) { if (samp && i < 30) xi = *(const f32x4*)(st + (size_t)i * DC);
                               else if (samp || t0 + i >= 0) xi = up4(*(const u32x2*)(zb + ((ptrdiff_t)i - 30) * ZLD)); }
                xw[j] = xi; }
#pragma unroll
            for (int kk = 0; kk < 8; ++kk) { const int k = 8 * kb + kk; const f32x4 w = (k <= 30) ? *(const f32x4*)(cw + (size_t)k * DC) : zero4;
#pragma unroll
                for (int o = 0; o < 8; ++o) acc[o] += w * xw[o + kk]; }
        }
#pragma unroll
        for (int o = 0; o < 8; ++o) { const int row = 128 * c + rb + o;
            const f32x4 v = acc[o] + bias; const float mean = wave_sum((v[0] + v[1]) + (v[2] + v[3])) * (1.0f / DC);
            const f32x4 d = v - mean; const float rstd = rsqrtf(wave_sum(pg8::sumsq4(d)) * (1.0f / DC) + EPS);
            const f32x4 yn = d * rstd * lg + lb; const f32x4 y = yn * pg8::sigm4(yn);
            const float rs = rsqrtf(wave_sum(pg8::sumsq4(y)) * (1.0f / DC) + EPS);
            *(u32x2*)(MIX + (size_t)row * DM + DA + DB + col) = pk4(y * rs); }
        if (samp) { float* onc = F.out + O_NCS + ((size_t)(l * 128 + q) * 30) * DC + col;
#pragma unroll 2
            for (int i = 0; i < 22; ++i) *(f32x4*)(onc + (size_t)i * DC) = *(const f32x4*)(st + (size_t)(8 + i) * DC);
#pragma unroll 2
            for (int o = 0; o < 8; ++o) *(f32x4*)(onc + (size_t)(22 + o) * DC) = up4(*(const u32x2*)(zb + (size_t)o * ZLD)); }
        else if ((c & 15) == 15) { float* onc = F.out + O_NCP + ((size_t)(l * 8 + (c >> 4)) * 30) * DC + col;
#pragma unroll 2
            for (int o = 0; o < 8; ++o) if (rb + o >= 98) *(f32x4*)(onc + (size_t)(rb + o - 98) * DC) = up4(*(const u32x2*)(zb + (size_t)o * ZLD)); }
    }
}
__device__ __forceinline__ void mix_b(const Frame& F, const Args& A, int l, int c) {
    const bf16* ZB = (const bf16*)(F.ws + WS_ZACT); bf16* MIX = (bf16*)(F.ws + WS_MIX);
    constexpr int VS = 392;
    LAS bf16* vn = (LAS bf16*)(F.lds + RING_OFF);
    const bool samp = (c >= 128); int lane_ = F.lane; asm volatile("" : "+v"(lane_)); const int w = F.wave, lane = lane_;
    {
        const bool act = lane < 48; const int col = 8 * (act ? lane : 0);
        f32x4 g0 = *(const f32x4*)(A.in[9] + l * DB + col), g1 = *(const f32x4*)(A.in[9] + l * DB + col + 4), b0 = *(const f32x4*)(A.in[10] + l * DB + col), b1 = *(const f32x4*)(A.in[10] + l * DB + col + 4);
#pragma unroll 2
        for (int rr = 0; rr < 16; ++rr) { const int rowc = 16 * w + rr, row = 128 * c + rowc;
            const v4u pv = *(const v4u*)(ZB + (size_t)row * ZLD + Z_V + col);
            f32x4 v0 = (f32x4){pg8::bf_lo(pv.x), pg8::bf_hi(pv.x), pg8::bf_lo(pv.y), pg8::bf_hi(pv.y)}, v1 = (f32x4){pg8::bf_lo(pv.z), pg8::bf_hi(pv.z), pg8::bf_lo(pv.w), pg8::bf_hi(pv.w)};
            float s = (v0[0] + v0[1]) + (v0[2] + v0[3]) + (v1[0] + v1[1]) + (v1[2] + v1[3]); if (!act) s = 0.f;
            const float mean = wave_sum(s) * (1.0f / DB);
            v0 = v0 - mean; v1 = v1 - mean; float qv = pg8::sumsq4(v0) + pg8::sumsq4(v1); if (!act) qv = 0.f;
            const float rstd = rsqrtf(wave_sum(qv) * (1.0f / DB) + EPS);
            v0 = v0 * rstd * g0 + b0; v1 = v1 * rstd * g1 + b1;
            if (act) { v4u o; o.x = pk_bf16(v0[0], v0[1]); o.y = pk_bf16(v0[2], v0[3]); o.z = pk_bf16(v1[0], v1[1]); o.w = pk_bf16(v1[2], v1[3]);
                *(LAS v4u*)(vn + rowc * VS + col) = o;
                if (samp) { float* o7 = F.out + O_NVS + ((size_t)l * TS + (row - TP)) * DB + col; *(f32x4*)o7 = v0; *(f32x4*)(o7 + 4) = v1; }
                else if ((c & 15) == 15) { float* o6 = F.out + O_NVP + ((size_t)(l * 8 + (c >> 4)) * 128 + rowc) * DB + col; *(f32x4*)o6 = v0; *(f32x4*)(o6 + 4) = v1; } }
        }
    }
    __syncthreads();
    f32x4 acc[6][4];
#pragma unroll
    for (int h = 0; h < 6; ++h)
#pragma unroll
        for (int mt = 0; mt < 4; ++mt) acc[h][mt] = (f32x4){0.f, 0.f, 0.f, 0.f};
    const int t = 16 * w + (lane & 15), g = lane >> 4, q4 = (lane & 15) >> 2, p = lane & 3;
    const int ks_lo = samp ? (w >> 1) : 0, ks_hi = w >> 1;
    const int tp = samp ? (t & 7) : t;
    const bool bvalid = samp ? (g == 2 * (w & 1) + ((lane & 15) >> 3)) : true;
#pragma unroll 1
    for (int ks = ks_lo; ks <= ks_hi; ++ks) {
        const int s0 = samp ? 0 : 32 * ks + 8 * g;
#pragma unroll
        for (int h = 0; h < 6; ++h) {
            const float* wp = A.in[11] + ((size_t)(l * 6 + h) * 128 + tp) * 128 + s0;
            const f32x4 a = *(const f32x4*)wp, b = *(const f32x4*)(wp + 4);
            float wv[8] = {a[0], a[1], a[2], a[3], b[0], b[1], b[2], b[3]};
#pragma unroll
            for (int j = 0; j < 8; ++j) wv[j] = (bvalid && (s0 + j <= tp)) ? wv[j] : 0.f;
            bf16x8 bfrag; { v4u o; o.x = pk_bf16(wv[0], wv[1]); o.y = pk_bf16(wv[2], wv[3]); o.z = pk_bf16(wv[4], wv[5]); o.w = pk_bf16(wv[6], wv[7]); bfrag = __builtin_bit_cast(bf16x8, o); }
#pragma unroll
            for (int mt = 0; mt < 4; ++mt) { const int d0 = 64 * h + 16 * mt;
                const LAS bf16* ap = vn + (32 * ks + 8 * g + q4) * VS + d0 + 4 * p;
                const v4i16_t lo = __builtin_amdgcn_ds_read_tr16_b64_v4i16((LAS v4i16_t*)ap), hi = __builtin_amdgcn_ds_read_tr16_b64_v4i16((LAS v4i16_t*)(ap + 4 * VS));
                bf16x8 afrag; afrag[0] = lo[0]; afrag[1] = lo[1]; afrag[2] = lo[2]; afrag[3] = lo[3]; afrag[4] = hi[0]; afrag[5] = hi[1]; afrag[6] = hi[2]; afrag[7] = hi[3];
                acc[h][mt] = __builtin_amdgcn_mfma_f32_16x16x32_bf16(afrag, bfrag, acc[h][mt], 0, 0, 0); }
        }
    }
    const int row = 128 * c + t; float qs = 0.f;
#pragma unroll
    for (int h = 0; h < 6; ++h) { const float bs = A.in[12][(size_t)(l * 6 + h) * 128 + tp];
#pragma unroll
        for (int mt = 0; mt < 4; ++mt) { const int col = 64 * h + 16 * mt + 4 * g;
            const f32x4 u4 = up4(*(const u32x2*)(ZB + (size_t)row * ZLD + Z_U + col)); acc[h][mt] = u4 * (acc[h][mt] + bs); qs += pg8::sumsq4(acc[h][mt]); } }
    qs += __shfl_xor(qs, 16); qs += __shfl_xor(qs, 32);
    const float rs = rsqrtf(qs * (1.0f / DB) + EPS);
#pragma unroll
    for (int h = 0; h < 6; ++h)
#pragma unroll
        for (int mt = 0; mt < 4; ++mt) *(u32x2*)(MIX + (size_t)row * DM + DA + 64 * h + 16 * mt + 4 * g) = pk4(acc[h][mt] * rs);
    __syncthreads();
}
__device__ __forceinline__ void mixer_phase(const Frame& F, const Args& A, int l) {
    for (int u = blockIdx.x; u < 3 * 136; u += F.G) {
        if (u < 136) mix_b(F, A, l, u); else if (u < 272) mix_c(F, A, l, u - 136); else mix_a(F, A, l, u - 272);
    }
    if (l + 1 < NL) convert_p(F, A, l + 1, blockIdx.x * NWAVES + F.wave, F.G * NWAVES);
}
__device__ __forceinline__ void final_phase(const Frame& F, const Args& A) {
    const float* ss = (const float*)(F.ws + WS_SS);
    for (int m = blockIdx.x * NWAVES + F.wave; m < TT; m += F.G * NWAVES) {
        const float rs = rsqrtf(pg8::row_ss(ss, m) * (1.0f / DM) + EPS); float* hr = F.out + (size_t)m * DM;
#pragma unroll
        for (int j = 0; j < 4; ++j) { const int col = 256 * j + 4 * F.lane; const f32x4 v = *(const f32x4*)(hr + col), gg = *(const f32x4*)(A.in[28] + col); *(f32x4*)(hr + col) = v * rs * gg; }
    }
}

__global__ void __launch_bounds__(NWAVES * 64, 2) mk_fwd(Args args) {
    extern __shared__ __attribute__((aligned(16))) unsigned char lds[];
    Frame F;
    F.lds = (LAS unsigned char*)lds; F.MISC = (volatile LAS unsigned*)(F.lds + MISC_OFF);
    F.tid = threadIdx.x; F.lane = F.tid & 63; F.wave = __builtin_amdgcn_readfirstlane(F.tid >> 6); F.G = gridDim.x;
    F.out = args.out; F.ws = args.ws; F.ctl = (gu32*)(args.ws + WS_CTL);
    for (int u = F.tid; u < (LDS_BYTES - LDSCTL_OFF) / 4; u += NWAVES * 64) ((LAS unsigned*)(F.lds + LDSCTL_OFF))[u] = 0u;
    __syncthreads();
    XcdBarrier bar; bar.bar = (unsigned*)(F.ctl + CW_BAR); bar.x = 0; bar.st = nullptr;
    if (N_LAUNCHES == 1) bar = xcd_barrier_post((unsigned*)(F.ctl + CW_BAR), F.MISC + 8);
    const int lo = args.ph_lo, hi = args.ph_hi;
#define IN(k) (lo <= (k) && (k) < hi)
#define SEAM(k) do { if (IN(k) && IN((k) + 1)) xcd_barrier(bar); } while (0)
    float* ssb = (float*)(args.ws + WS_SS);
    bf16* ZB = (bf16*)(args.ws + WS_ZACT); bf16* ACT = ZB; bf16* MIX = (bf16*)(args.ws + WS_MIX); bf16* PROJ = (bf16*)(args.ws + WS_PROJ); bf16* PB = (bf16*)(args.ws + WS_PB);

    if (IN(0)) { p0_prologue(F, args); } SEAM(0);
#pragma unroll 1
    for (int l = 0; l < NL; ++l) {
        const int pb = 1 + 6 * l; bf16* hcur = (bf16*)(args.ws + ((l & 1) ? WS_HB1 : WS_HB0)); bf16* hnxt = (bf16*)(args.ws + ((l & 1) ? WS_HB0 : WS_HB1));
        float* ssA = ssb; float* ssB = ssb + SS_STRIDE; float* ssC = ssb + 2 * SS_STRIDE; float* ssA2 = ssA;
        if (IN(pb)) {
            { pg8::Gemm g{hcur, (bf16*)(args.ws + WS_WIN) + (size_t)l * ZN * DM, TT, ZN, DM}; pg8::StaticOrder S; S.init(TT, ZN, F.G, (int)blockIdx.x);
              pg8::EpiZ E{ZB, ssA, ZLD}; pg8::gemm_phase<pg8::EpiZ, pg8::StaticOrder, true, true>(F.lds + RING_OFF, g, S, E); }
            { pg8::Gemm g{PB, (bf16*)(args.ws + WS_WPP) + (size_t)l * DM * DPLE, TT, DM, DPLE}; pg8::StaticOrder S; S.init(TT, DM, F.G, F.G == 256 ? (int)((blockIdx.x + 88u) & 255u) : (int)blockIdx.x);
              pg8::EpiPlain E{PROJ, DM}; pg8::gemm_phase<pg8::EpiPlain, pg8::StaticOrder, true, true>(F.lds + RING_OFF, g, S, E); }
        } SEAM(pb);
        if (IN(pb + 1)) { mixer_phase(F, args, l); } SEAM(pb + 1);
        if (IN(pb + 2)) {
            pg8::Gemm g{MIX, (bf16*)(args.ws + WS_WOUT) + (size_t)l * DM * DM, TT, DM, DM}; pg8::StaticOrder S; S.init(TT, DM, F.G, (int)blockIdx.x);
            pg8::EpiRes E{l == 0 ? args.in[0] : F.out, l == 0 ? args.in[1] : F.out + (size_t)TP * DM, F.out, hnxt, ssB};
            pg8::gemm_phase<pg8::EpiRes, pg8::StaticOrder, true, true>(F.lds + RING_OFF, g, S, E);
        } SEAM(pb + 2);
        if (IN(pb + 3)) {
            pg8::Gemm g{hnxt, (bf16*)(args.ws + WS_WGU) + (size_t)l * GUN * DM, TT, GUN, DM}; pg8::StaticOrder S; S.init(TT, GUN, F.G, (int)blockIdx.x);
            pg8::EpiGU E{ACT, ssB, DFF}; pg8::gemm_phase<pg8::EpiGU, pg8::StaticOrder, true, true>(F.lds + RING_OFF, g, S, E);
        } SEAM(pb + 3);
        if (IN(pb + 4)) {
            pg8::Gemm g{ACT, (bf16*)(args.ws + WS_WDN) + (size_t)l * DM * DFF, TT, DM, DFF}; pg8::StaticOrder S; S.init(TT, DM, F.G, (int)blockIdx.x);
            pg8::EpiRes E{F.out, F.out + (size_t)TP * DM, F.out, hcur, ssC}; pg8::gemm_phase<pg8::EpiRes, pg8::StaticOrder, true, true>(F.lds + RING_OFF, g, S, E);
        } SEAM(pb + 4);
        if (IN(pb + 5)) {
            pg8::Gemm g{hcur, (bf16*)(args.ws + WS_WPG) + (size_t)l * DM * DM, TT, DM, DM}; pg8::StaticOrder S; S.init(TT, DM, F.G, (int)blockIdx.x);
            pg8::EpiPle E{F.out, hnxt, PROJ, ssC, ssA2}; pg8::gemm_phase<pg8::EpiPle, pg8::StaticOrder, true, true>(F.lds + RING_OFF, g, S, E);
        } SEAM(pb + 5);
    }
    if (IN(25)) final_phase(F, args);
#undef IN
#undef SEAM
}

extern "C" void kernel_launch(void* const* d_in, const int* in_sizes, int n_in, void* d_out, int out_size, void* d_ws, size_t ws_size, hipStream_t stream) {
    static int grid = 0;
    if (grid == 0) {
        if (n_in != 29 || in_sizes[0] != TP * DM || (size_t)out_size != O_END || ws_size < WS_END) { fprintf(stderr, "kernel_launch: unexpected shapes: n_in %d in0 %d out %d ws %zu (need %zu)\n", n_in, n_in > 0 ? in_sizes[0] : -1, out_size, ws_size, (size_t)WS_END); grid = -1; return; }
        int dev = 0, cus = 0, per_cu = 0;
        if (hipGetDevice(&dev) != hipSuccess || hipDeviceGetAttribute(&cus, hipDeviceAttributeMultiprocessorCount, dev) != hipSuccess) { grid = -1; return; }
        if (hipFuncSetAttribute((const void*)mk_fwd, hipFuncAttributeMaxDynamicSharedMemorySize, LDS_BYTES) != hipSuccess) { fprintf(stderr, "kernel_launch: hipFuncSetAttribute failed\n"); grid = -1; return; }
        if (hipOccupancyMaxActiveBlocksPerMultiprocessor(&per_cu, (const void*)mk_fwd, NWAVES * 64, LDS_BYTES) != hipSuccess || per_cu < 1) fprintf(stderr, "kernel_launch: occupancy query reports %d blocks per CU\n", per_cu);
        (void)hipGetLastError();
        grid = cus;
        if (grid != 256) fprintf(stderr, "kernel_launch: %d CUs (tuned for 256)\n", grid);
    }
    if (grid < 0) return;
    if (hipMemsetAsync((char*)d_ws + WS_CTL, 0, CTL_ZERO_BYTES, stream) != hipSuccess) { fprintf(stderr, "kernel_launch: memset failed\n"); return; }
    Args a{};
    for (int i = 0; i < 29; ++i) a.in[i] = (const float*)d_in[i];
    a.out = (float*)d_out; a.ws = (unsigned char*)d_ws;
    if (N_LAUNCHES == 1) { a.ph_lo = 0; a.ph_hi = N_PHASES; hipLaunchKernelGGL(mk_fwd, dim3(grid), dim3(NWAVES * 64), LDS_BYTES, stream, a); }
    else for (int p = 0; p < N_PHASES; ++p) { a.ph_lo = p; a.ph_hi = p + 1; hipLaunchKernelGGL(mk_fwd, dim3(grid), dim3(NWAVES * 64), LDS_BYTES, stream, a); }
}
```

```cpp
#include <hip/hip_runtime.h>
#include <cstdio>
#include <cstdint>
namespace pg8 {
#define PG8_LAS __attribute__((address_space(3)))
typedef unsigned short bf16_t;
typedef short bf16x8 __attribute__((ext_vector_type(8)));
typedef float f32x4 __attribute__((ext_vector_type(4)));
typedef unsigned u32x4 __attribute__((ext_vector_type(4)));
constexpr int BM = 256, BK = 64, HALF = 128, HTB = HALF * BK * 2  , STAGE_BYTES = 8 * HTB, NXCD = 8, WGM = 8;

__host__ __device__ __forceinline__ int lds_byte(int r, int c) { const int st = (r >> 4) * 2 + (c >> 5), rr = r & 15, cc = c & 31, ob = rr * 64 + cc * 2; return st * 1024 + (ob ^ (((ob >> 9) & 1) << 5)); }
__host__ __device__ __forceinline__ void stage_rc(int b, int& R, int& C) { const int st = b / 1024, sb = b % 1024, swz = sb ^ (((sb >> 9) & 1) << 5); R = (st >> 1) * 16 + swz / 64; C = (st & 1) * 32 + (swz % 64) / 2; }
__host__ __device__ __forceinline__ int perm32(int rho) { const int n = rho >> 4, i = rho & 15; return 8 * (i >> 2) + 4 * n + (i & 3); }

struct Unit { int pm, pn; };
struct Gemm { const bf16_t* A; const bf16_t* Bt; int M, N, K; };

struct StaticOrder {
    int nM, nN, nwg, G, c;
    __host__ __device__ void init(int M, int N, int G_, int c_) { nM = M / BM; nN = N / BM; nwg = nM * nN; G = G_; c = c_; }
    __host__ __device__ bool next(int i, Unit& u) const {
        const long L = (long)i * G + c; if (L >= nwg) return false;
        int wgid = (int)L; { const int q = nwg / NXCD, r = nwg % NXCD, xcd = wgid % NXCD, off = wgid / NXCD; wgid = (xcd < r ? xcd * (q + 1) : r * (q + 1) + (xcd - r) * q) + off; }
        const int nig = WGM * nN, gid = wgid / nig, fm = gid * WGM, gsz = (nM - fm) < WGM ? (nM - fm) : WGM;
        u.pm = fm + ((wgid % nig) % gsz); u.pn = (wgid % nig) / gsz; return true;
    }
    __device__ __forceinline__ void a_ready(const Unit&) const {}
    __device__ __forceinline__ void done(const Unit&) const {}
};

__device__ __forceinline__ unsigned cvt_pk_bf16(float lo, float hi) { unsigned r; asm volatile("v_cvt_pk_bf16_f32 %0, %1, %2" : "=v"(r) : "v"(lo), "v"(hi)); return r; }
typedef float f32x2 __attribute__((ext_vector_type(2)));
__device__ __forceinline__ f32x2 gelu_pk(f32x2 v) {
    const f32x2 av = __builtin_elementwise_abs(v), d = av * 0.2316418882f + 1.0f;
    f32x2 t; t.x = __builtin_amdgcn_rcpf(d.x); t.y = __builtin_amdgcn_rcpf(d.y);
    f32x2 q = t * 0.5307027145f + (-0.7265760135f); q = q * t + 0.7107068705f; q = q * t + (-0.142248368f); q = q * t + 0.127414796f; q = q * t;
    const f32x2 s = (v * v) * (-0.72134752044f);
    f32x2 e; e.x = __builtin_amdgcn_exp2f(s.x); e.y = __builtin_amdgcn_exp2f(s.y);
    const f32x2 m = v * (q * e), r = v - m;
    f32x2 o; o.x = v.x < 0.f ? m.x : r.x; o.y = v.y < 0.f ? m.y : r.y; return o;
}

constexpr int TP_ROWS = 16384;
constexpr float RMS_EPS = 1e-6f;
__device__ __forceinline__ float sigm(float x) { return __builtin_amdgcn_rcpf(1.0f + __builtin_amdgcn_exp2f(-1.44269504089f * x)); }
__device__ __forceinline__ f32x4 sigm4(f32x4 x) { return (f32x4){sigm(x[0]), sigm(x[1]), sigm(x[2]), sigm(x[3])}; }
__device__ __forceinline__ f32x4 gelu4(f32x4 x) { const f32x2 a = gelu_pk((f32x2){x[0], x[1]}), b = gelu_pk((f32x2){x[2], x[3]}); return (f32x4){a.x, a.y, b.x, b.y}; }
__device__ __forceinline__ void st_bf16x8(bf16_t* p, f32x4 v0, f32x4 v1) { u32x4 w; w.x = cvt_pk_bf16(v0[0], v0[1]); w.y = cvt_pk_bf16(v0[2], v0[3]); w.z = cvt_pk_bf16(v1[0], v1[1]); w.w = cvt_pk_bf16(v1[2], v1[3]); *(u32x4*)p = w; }
__device__ __forceinline__ float bf_lo(unsigned w) { return __uint_as_float(w << 16); }
__device__ __forceinline__ float bf_hi(unsigned w) { return __uint_as_float(w & 0xffff0000u); }
__device__ __forceinline__ float sumsq4(f32x4 v) { return (v[0] * v[0] + v[1] * v[1]) + (v[2] * v[2] + v[3] * v[3]); }
__device__ __forceinline__ float row_ss(const float* ssp, int row) { const f32x4* p = (const f32x4*)(ssp + (size_t)row * 16); const f32x4 a = p[0], b = p[1], c = p[2], d = p[3];
    return (((a[0] + a[1]) + (a[2] + a[3])) + ((b[0] + b[1]) + (b[2] + b[3]))) + (((c[0] + c[1]) + (c[2] + c[3])) + ((d[0] + d[1]) + (d[2] + d[3]))); }

struct EpiZ {
    static constexpr bool PERM = true, AFTER_DRAIN = false;
    bf16_t* Z; const float* ss; int zld;
    __device__ __forceinline__ void operator()(const f32x4 (&acc)[2][2][4][2], const Unit& u, int wr, int wc, int fr, int fq) const {
        const int row0 = u.pm * BM + wr * 64 + fr, cl = wc * 32 + 8 * fq, pn = u.pn;
#pragma unroll
        for (int ai = 0; ai < 2; ++ai)
#pragma unroll
            for (int m = 0; m < 4; ++m) {
                const int row = row0 + ai * HALF + m * 16; const float rs = rsqrtf(row_ss(ss, row) * (1.0f / 1024.0f) + RMS_EPS); bf16_t* zr = Z + (size_t)row * zld;
                if (pn < 3) { const f32x4 v0 = (acc[ai][0][m][0] * rs) * (acc[ai][1][m][0] * rs), v1 = (acc[ai][0][m][1] * rs) * (acc[ai][1][m][1] * rs); st_bf16x8(zr + 128 * pn + cl, v0, v1); }
                else if (pn < 5) { const f32x4 v0 = (acc[ai][0][m][0] * rs) * sigm4(acc[ai][1][m][0] * rs), v1 = (acc[ai][0][m][1] * rs) * sigm4(acc[ai][1][m][1] * rs); st_bf16x8(zr + 384 + 128 * (pn - 3) + cl, v0, v1); }
                else {
#pragma unroll
                    for (int bj = 0; bj < 2; ++bj) { const int kb = 2 * pn + bj; if (kb < 19) { f32x4 v0 = acc[ai][bj][m][0] * rs, v1 = acc[ai][bj][m][1] * rs; if (kb >= 13) { v0 = gelu4(v0); v1 = gelu4(v1); } st_bf16x8(zr + 640 + (kb - 10) * 128 + cl, v0, v1); } }
                }
            }
    }
};
struct EpiPlain {
    static constexpr bool PERM = true, AFTER_DRAIN = false;
    bf16_t* O; int ldc;
    __device__ __forceinline__ void operator()(const f32x4 (&acc)[2][2][4][2], const Unit& u, int wr, int wc, int fr, int fq) const {
        const int row0 = u.pm * BM + wr * 64 + fr, col0 = u.pn * BM + wc * 32 + 8 * fq;
#pragma unroll
        for (int ai = 0; ai < 2; ++ai)
#pragma unroll
            for (int m = 0; m < 4; ++m) { bf16_t* rowp = O + (size_t)(row0 + ai * HALF + m * 16) * ldc + col0;
#pragma unroll
                for (int bj = 0; bj < 2; ++bj) st_bf16x8(rowp + bj * HALF, acc[ai][bj][m][0], acc[ai][bj][m][1]); }
    }
};
struct EpiRes {
    static constexpr bool PERM = true, AFTER_DRAIN = false;
    const float* hin_p; const float* hin_s; float* hout; bf16_t* hb; float* ssq;
    __device__ __forceinline__ void operator()(const f32x4 (&acc)[2][2][4][2], const Unit& u, int wr, int wc, int fr, int fq) const {
        const int row0 = u.pm * BM + wr * 64 + fr, col0 = u.pn * BM + wc * 32 + 8 * fq;
        const bool isp = (u.pm * BM < TP_ROWS); const float* hin = isp ? hin_p : hin_s; const int rsub = isp ? 0 : TP_ROWS;
#pragma unroll
        for (int ai = 0; ai < 2; ++ai)
#pragma unroll
            for (int m = 0; m < 4; ++m) { const int row = row0 + ai * HALF + m * 16; const size_t off = (size_t)row * 1024 + col0, offi = (size_t)(row - rsub) * 1024 + col0; float q = 0.f;
#pragma unroll
                for (int bj = 0; bj < 2; ++bj) { const f32x4 a0 = *(const f32x4*)(hin + offi + bj * HALF), a1 = *(const f32x4*)(hin + offi + bj * HALF + 4);
                    const f32x4 v0 = a0 + acc[ai][bj][m][0], v1 = a1 + acc[ai][bj][m][1];
                    *(f32x4*)(hout + off + bj * HALF) = v0; *(f32x4*)(hout + off + bj * HALF + 4) = v1; st_bf16x8(hb + off + bj * HALF, v0, v1); q += sumsq4(v0) + sumsq4(v1); }
                q += __shfl_xor(q, 16); q += __shfl_xor(q, 32);
                if (fq == 0) ssq[(size_t)row * 16 + 4 * u.pn + wc] = q; }
    }
};
struct EpiGU {
    static constexpr bool PERM = true, AFTER_DRAIN = false;
    bf16_t* O; const float* ss; int ldc;
    __device__ __forceinline__ void operator()(const f32x4 (&acc)[2][2][4][2], const Unit& u, int wr, int wc, int fr, int fq) const {
        const int row0 = u.pm * BM + wr * 64 + fr, col0 = u.pn * HALF + wc * 32 + 8 * fq;
#pragma unroll
        for (int ai = 0; ai < 2; ++ai)
#pragma unroll
            for (int m = 0; m < 4; ++m) { const int row = row0 + ai * HALF + m * 16; const float rs = rsqrtf(row_ss(ss, row) * (1.0f / 1024.0f) + RMS_EPS);
                const f32x4 g0 = acc[ai][0][m][0] * rs, g1 = acc[ai][0][m][1] * rs, u0 = acc[ai][1][m][0] * rs, u1 = acc[ai][1][m][1] * rs;
                st_bf16x8(O + (size_t)row * ldc + col0, g0 * sigm4(g0) * u0, g1 * sigm4(g1) * u1); }
    }
};
struct EpiPle {
    static constexpr bool PERM = true, AFTER_DRAIN = false;
    float* h; bf16_t* hb; const bf16_t* proj; const float* ss; float* ssq;
    __device__ __forceinline__ void operator()(const f32x4 (&acc)[2][2][4][2], const Unit& u, int wr, int wc, int fr, int fq) const {
        const int row0 = u.pm * BM + wr * 64 + fr, col0 = u.pn * BM + wc * 32 + 8 * fq;
#pragma unroll
        for (int ai = 0; ai < 2; ++ai)
#pragma unroll
            for (int m = 0; m < 4; ++m) { const int row = row0 + ai * HALF + m * 16; const size_t off = (size_t)row * 1024 + col0; float q = 0.f;
                const float rs = rsqrtf(row_ss(ss, row) * (1.0f / 1024.0f) + RMS_EPS);
#pragma unroll
                for (int bj = 0; bj < 2; ++bj) { const f32x4 a0 = *(const f32x4*)(h + off + bj * HALF), a1 = *(const f32x4*)(h + off + bj * HALF + 4);
                    const u32x4 pw = *(const u32x4*)(proj + off + bj * HALF);
                    const f32x4 p0 = (f32x4){bf_lo(pw.x), bf_hi(pw.x), bf_lo(pw.y), bf_hi(pw.y)}, p1 = (f32x4){bf_lo(pw.z), bf_hi(pw.z), bf_lo(pw.w), bf_hi(pw.w)};
                    const f32x4 v0 = a0 + sigm4(acc[ai][bj][m][0] * rs) * p0, v1 = a1 + sigm4(acc[ai][bj][m][1] * rs) * p1;
                    *(f32x4*)(h + off + bj * HALF) = v0; *(f32x4*)(h + off + bj * HALF + 4) = v1; st_bf16x8(hb + off + bj * HALF, v0, v1); q += sumsq4(v0) + sumsq4(v1); }
                q += __shfl_xor(q, 16); q += __shfl_xor(q, 32);
                if (fq == 0) ssq[(size_t)row * 16 + 4 * u.pn + wc] = q; }
    }
};
template <class Epi, class Sched, bool ALIGN_EPI = false, bool SP2 = false>
__device__ __forceinline__ void gemm_phase(PG8_LAS unsigned char* lds, const Gemm g, const Sched& S, const Epi& E) {
    int tid_ = threadIdx.x; asm volatile("" : "+v"(tid_));
    const int tid = tid_, wid = __builtin_amdgcn_readfirstlane(tid >> 6), lane = tid & 63, wr = wid >> 2, wc = wid & 3, fr = lane & 15, fq = lane >> 4;
    int K_ = g.K; asm volatile("" : "+s"(K_));
    const int K = K_, nt = K / BK;
    unsigned voffA[2], voffB[2];
#pragma unroll
    for (int i = 0; i < 2; ++i) { int R, C; stage_rc(tid * 16 + i * 8192, R, C); const int Rb = Epi::PERM ? ((R & ~31) + perm32(R & 31)) : R;
        voffA[i] = (unsigned)(R * K + C) * 2u; voffB[i] = (unsigned)(Rb * K + C) * 2u; }
    const size_t kstep = (size_t)(BK * 2);
    const size_t hstep = (size_t)HALF * K * 2;
    const size_t tstep = 2 * hstep;
    const unsigned ldsw = (unsigned)wid * 1024u;
    const int aoff = lds_byte(wr * 64 + fr, fq * 8), boff = lds_byte(wc * 32 + fr, fq * 8);
#define PG8_SA(b, h) (((b) * 2 + (h)) * HTB)
#define PG8_SB(b, h) ((4 + (b) * 2 + (h)) * HTB)
#define PG8_STAGE(bufoff, gbase, voff) do { _Pragma("unroll") for (int _i = 0; _i < 2; ++_i) \
        __builtin_amdgcn_global_load_lds((const unsigned*)((const char*)(gbase) + (voff)[_i]), (PG8_LAS unsigned*)(lds + (bufoff) + ldsw + _i * 8192), 16, 0, 0); } while (0)
#define PG8_LDA(dst, b, h) do { _Pragma("unroll") for (int m = 0; m < 4; ++m) _Pragma("unroll") for (int k = 0; k < 2; ++k) dst[m][k] = *(const PG8_LAS bf16x8*)(lds + PG8_SA(b, h) + aoff + m * 2048 + k * 1024); } while (0)
#define PG8_LDB(dst, b, h) do { _Pragma("unroll") for (int n = 0; n < 2; ++n) _Pragma("unroll") for (int k = 0; k < 2; ++k) dst[n][k] = *(const PG8_LAS bf16x8*)(lds + PG8_SB(b, h) + boff + n * 2048 + k * 1024); } while (0)
#define PG8_MMA(ai, bj, At, Bt) do { __builtin_amdgcn_s_setprio(1); _Pragma("unroll") for (int m = 0; m < 4; ++m) _Pragma("unroll") for (int n = 0; n < 2; ++n) _Pragma("unroll") for (int k = 0; k < 2; ++k) \
        acc[ai][bj][m][n] = __builtin_amdgcn_mfma_f32_16x16x32_bf16(Bt[n][k], At[m][k], acc[ai][bj][m][n], 0, 0, 0); __builtin_amdgcn_s_setprio(0); } while (0)
#define PG8_WAIT_V(n) asm volatile("s_waitcnt vmcnt(" #n ")" ::: "memory")
#define PG8_WAIT_L(n) asm volatile("s_waitcnt lgkmcnt(" #n ")" ::: "memory")
#define PG8_BAR __builtin_amdgcn_s_barrier()
#define PG8_SCHED __builtin_amdgcn_sched_barrier(0)
    Unit cur, nxt; int ui = 0;
    if (!S.next(0, cur)) return;
    f32x4 acc[2][2][4][2];
#pragma unroll
    for (int a = 0; a < 2; ++a)
#pragma unroll
        for (int b = 0; b < 2; ++b)
#pragma unroll
            for (int m = 0; m < 4; ++m)
#pragma unroll
                for (int n = 0; n < 2; ++n) acc[a][b][m][n] = (f32x4){0.f, 0.f, 0.f, 0.f};
    bf16x8 At[4][2], B0[2][2], B1[2][2];
    const char* cA = (const char*)g.A + (size_t)cur.pm * tstep; const char* cB = (const char*)g.Bt + (size_t)cur.pn * tstep;
    S.a_ready(cur);
    if constexpr (SP2) {
        PG8_STAGE(PG8_SB(0, 0), cB, voffB); PG8_STAGE(PG8_SB(0, 1), cB + hstep, voffB); PG8_STAGE(PG8_SA(0, 0), cA, voffA); PG8_STAGE(PG8_SA(0, 1), cA + hstep, voffA);
        if (wr == 1) PG8_BAR;
        PG8_WAIT_V(2); PG8_BAR;
        PG8_STAGE(PG8_SB(1, 0), cB + kstep, voffB); PG8_STAGE(PG8_SA(1, 0), cA + kstep, voffA); PG8_STAGE(PG8_SB(1, 1), cB + hstep + kstep, voffB);
        PG8_WAIT_V(6); PG8_BAR;
    } else {
        PG8_STAGE(PG8_SB(0, 0), cB, voffB); PG8_STAGE(PG8_SA(0, 0), cA, voffA); PG8_STAGE(PG8_SB(0, 1), cB + hstep, voffB); PG8_STAGE(PG8_SA(0, 1), cA + hstep, voffA);
        if (wr == 1) PG8_BAR;
        PG8_WAIT_V(4); PG8_BAR;
        PG8_STAGE(PG8_SB(1, 0), cB + kstep, voffB); PG8_STAGE(PG8_SA(1, 0), cA + kstep, voffA); PG8_STAGE(PG8_SB(1, 1), cB + hstep + kstep, voffB);
        PG8_WAIT_V(6); PG8_BAR;
    }
    for (;;) {
        const bool has_next = S.next(ui + 1, nxt);
        const char* nA = has_next ? (const char*)g.A + (size_t)nxt.pm * tstep : cA; const char* nB = has_next ? (const char*)g.Bt + (size_t)nxt.pn * tstep : cB;
        for (int t = 0; t < nt; t += 2) {
            const bool last = (t == nt - 2);
            const char* a1 = cA + (size_t)(t + 1) * kstep;
            const char* a2 = last ? nA : cA + (size_t)(t + 2) * kstep; const char* b2 = last ? nB : cB + (size_t)(t + 2) * kstep;
            const char* a3 = a2 + kstep; const char* b3 = b2 + kstep;
            if (last && has_next) S.a_ready(nxt);
            if constexpr (SP2) {
            PG8_LDB(B0, 0, 0); PG8_LDB(B1, 0, 1); PG8_SCHED; PG8_LDA(At, 0, 0); PG8_STAGE(PG8_SA(1, 1), a1 + hstep, voffA);
            PG8_WAIT_V(8); PG8_WAIT_L(0); PG8_BAR; PG8_MMA(0, 0, At, B0); PG8_MMA(0, 1, At, B1); PG8_BAR; PG8_SCHED;
            PG8_LDA(At, 0, 1); PG8_STAGE(PG8_SB(0, 0), b2, voffB); PG8_STAGE(PG8_SB(0, 1), b2 + hstep, voffB); PG8_STAGE(PG8_SA(0, 0), a2, voffA);
            PG8_WAIT_V(8); PG8_WAIT_L(0); PG8_BAR; PG8_MMA(1, 0, At, B0); PG8_MMA(1, 1, At, B1); PG8_BAR; PG8_SCHED;
            PG8_LDB(B0, 1, 0); PG8_LDB(B1, 1, 1); PG8_SCHED; PG8_LDA(At, 1, 0); PG8_STAGE(PG8_SA(0, 1), a2 + hstep, voffA);
            PG8_WAIT_V(8); PG8_WAIT_L(0); PG8_BAR; PG8_MMA(0, 0, At, B0); PG8_MMA(0, 1, At, B1); PG8_BAR; PG8_SCHED;
            PG8_LDA(At, 1, 1); PG8_STAGE(PG8_SB(1, 0), b3, voffB); PG8_STAGE(PG8_SB(1, 1), b3 + hstep, voffB); PG8_STAGE(PG8_SA(1, 0), a3, voffA);
            PG8_WAIT_V(8); PG8_WAIT_L(0); PG8_BAR; PG8_MMA(1, 0, At, B0); PG8_MMA(1, 1, At, B1); PG8_BAR; PG8_SCHED;
            } else {
            PG8_LDB(B0, 0, 0); PG8_SCHED; PG8_LDA(At, 0, 0); PG8_STAGE(PG8_SA(1, 1), a1 + hstep, voffA);
            PG8_WAIT_L(8); PG8_BAR; PG8_WAIT_L(0); PG8_MMA(0, 0, At, B0); PG8_BAR; PG8_SCHED;
            PG8_LDB(B1, 0, 1); PG8_STAGE(PG8_SB(0, 0), b2, voffB);
            PG8_BAR; PG8_WAIT_L(0); PG8_MMA(0, 1, At, B1); PG8_BAR;
            PG8_LDA(At, 0, 1); PG8_STAGE(PG8_SA(0, 0), a2, voffA);
            PG8_BAR; PG8_WAIT_L(0); PG8_MMA(1, 0, At, B0); PG8_BAR; PG8_SCHED;
            PG8_STAGE(PG8_SB(0, 1), b2 + hstep, voffB);
            PG8_WAIT_V(6); PG8_BAR; PG8_MMA(1, 1, At, B1); PG8_BAR;
            PG8_LDB(B0, 1, 0); PG8_SCHED; PG8_LDA(At, 1, 0); PG8_STAGE(PG8_SA(0, 1), a2 + hstep, voffA);
            PG8_WAIT_L(8); PG8_BAR; PG8_WAIT_L(0); PG8_MMA(0, 0, At, B0); PG8_BAR; PG8_SCHED;
            PG8_LDB(B1, 1, 1); PG8_STAGE(PG8_SB(1, 0), b3, voffB);
            PG8_BAR; PG8_WAIT_L(0); PG8_MMA(0, 1, At, B1); PG8_BAR;
            PG8_LDA(At, 1, 1); PG8_STAGE(PG8_SA(1, 0), a3, voffA);
            PG8_BAR; PG8_WAIT_L(0); PG8_MMA(1, 0, At, B0); PG8_BAR; PG8_SCHED;
            PG8_STAGE(PG8_SB(1, 1), b3 + hstep, voffB);
            PG8_WAIT_V(6); PG8_BAR; PG8_MMA(1, 1, At, B1); PG8_BAR;
            }
        }
        if constexpr (ALIGN_EPI) { if (wr == 0) PG8_BAR; }
        if constexpr (!Epi::AFTER_DRAIN) { E(acc, cur, wr, wc, fr, fq); S.done(cur); }
        if (!has_next) break;
#pragma unroll
        for (int a = 0; a < 2; ++a)
#pragma unroll
            for (int b = 0; b < 2; ++b)
#pragma unroll
                for (int m = 0; m < 4; ++m)
#pragma unroll
                    for (int n = 0; n < 2; ++n) acc[a][b][m][n] = (f32x4){0.f, 0.f, 0.f, 0.f};
        cur = nxt; cA = nA; cB = nB; ++ui;
        if constexpr (ALIGN_EPI) { if (wr == 1) PG8_BAR; }
    }
    PG8_WAIT_V(0);
    if constexpr (!ALIGN_EPI) { if (wr == 0) PG8_BAR; }
    PG8_BAR;
    if constexpr (Epi::AFTER_DRAIN) { E.fused(acc, cur, wr, wc, fr, fq, lds, wid, lane); S.done(cur); }
#undef PG8_SA
#undef PG8_SB
#undef PG8_STAGE
#undef PG8_LDA
#undef PG8_LDB
#undef PG8_MMA
#undef PG8_WAIT_V
#undef PG8_WAIT_L
#undef PG8_BAR
#undef PG8_SCHED
}
}
#define GAS __attribute__((address_space(1)))
#define LAS __attribute__((address_space(3)))
typedef unsigned short bf16;
typedef unsigned v4u __attribute__((ext_vector_type(4)));
typedef float f32x4 __attribute__((ext_vector_type(4)));
typedef short bf16x8 __attribute__((ext_vector_type(8)));
typedef GAS unsigned gu32;
typedef GAS unsigned long long gu64;
#define RLX_AGENT __ATOMIC_RELAXED, __HIP_MEMORY_SCOPE_AGENT
#define LDS_WAIT() asm volatile("s_waitcnt lgkmcnt(0)" ::: "memory")
#define VM_WAIT() asm volatile("s_waitcnt vmcnt(0)" ::: "memory")
__device__ __forceinline__ unsigned long long rt() { return __builtin_amdgcn_s_memrealtime(); }
__device__ __forceinline__ unsigned f2bf(float f) { unsigned u = __builtin_bit_cast(unsigned, f); return (u + 0x7fffu + ((u >> 16) & 1u)) >> 16; }
__device__ __forceinline__ unsigned pk2(float lo, float hi) { return f2bf(lo) | (f2bf(hi) << 16); }

#define XB_TMO      128
#define XB_XCNT(j)  (256  + 64 * (j))
#define XB_XSUB(j)  (1280 + 64 * (j))
#define XB_XGEN(j)  (2304 + 64 * (j))
#define XB_TOP      3328
#define XB_TOPGEN   3392
#define XCD_BAR_WORDS 3456
#define XB_SPIN_CAP (1u << 18)

__device__ __forceinline__ unsigned xb_ld(unsigned* p)              { return __hip_atomic_load(p, __ATOMIC_RELAXED, __HIP_MEMORY_SCOPE_AGENT); }
__device__ __forceinline__ unsigned xb_add(unsigned* p, unsigned v) { return __hip_atomic_fetch_add(p, v, __ATOMIC_RELAXED, __HIP_MEMORY_SCOPE_AGENT); }
__device__ __forceinline__ unsigned xb_xcc_id() { return (unsigned)__builtin_amdgcn_s_getreg((3 << 11) | 20) & 0xFu; }
#define XB_SPIN(cond, bar) do { unsigned _sp = 0; while (cond) { __builtin_amdgcn_s_sleep(1); \
    if ((++_sp & 255u) == 0u) { if (xb_ld(&(bar)[XB_TMO])) break; if (_sp > XB_SPIN_CAP) { atomicAdd(&(bar)[XB_TMO], 1u); break; } } } } while (0)

struct XcdBarrier {
    unsigned* bar; unsigned x;
    volatile LAS unsigned* st;
};

__device__ __forceinline__ XcdBarrier xcd_barrier_post(unsigned* bar, volatile LAS unsigned* st) {
    XcdBarrier b; b.bar = bar; b.x = xb_xcc_id(); b.st = st;
    if (threadIdx.x == 0) (void)xb_add(&bar[XB_XCNT(b.x)], 1u);
    return b;
}
__device__ __forceinline__ void xcd_barrier_complete(unsigned* bar, unsigned x, unsigned& nloc, unsigned& nx) {
    const unsigned G = gridDim.x * gridDim.y * gridDim.z;
    unsigned sum, cnt, mine, sp = 0u;
    for (;;) {
        sum = 0u; cnt = 0u; mine = 0u;
#pragma unroll
        for (unsigned j = 0; j < 16; ++j) { const unsigned c = xb_ld(&bar[XB_XCNT(j)]); sum += c; cnt += (c > 0u) ? 1u : 0u; mine = (j == x) ? c : mine; }
        if (sum == G) break;
        __builtin_amdgcn_s_sleep(1);
        if ((++sp & 255u) == 0u) { if (xb_ld(&bar[XB_TMO])) break; if (sp > XB_SPIN_CAP) { atomicAdd(&bar[XB_TMO], 1u); break; } }
    }
    nloc = mine > 0u ? mine : 1u; nx = cnt > 0u ? cnt : 1u;
}

__device__ __forceinline__ void xcd_barrier(const XcdBarrier& b) {
    asm volatile("s_waitcnt vmcnt(0)" ::: "memory");
    __syncthreads();
    if (threadIdx.x == 0) {
        unsigned* bar = b.bar;
        __builtin_amdgcn_s_waitcnt(0);
        unsigned nloc = b.st[0], nx = b.st[1];
        if (nloc == 0u) { xcd_barrier_complete(bar, b.x, nloc, nx); b.st[0] = nloc; b.st[1] = nx; }
        const unsigned old = xb_add(&bar[XB_XSUB(b.x)], 1u);
        const unsigned gen = old / nloc;
        if (old + 1u == (gen + 1u) * nloc) {
            __builtin_amdgcn_fence(__ATOMIC_RELEASE, "agent");
            asm volatile("s_waitcnt vmcnt(0)" ::: "memory");
            const unsigned og = xb_add(&bar[XB_TOP], 1u);
            const unsigned tg = og / nx;
            if (og + 1u == (tg + 1u) * nx) xb_add(&bar[XB_TOPGEN], 1u);
            else XB_SPIN(xb_ld(&bar[XB_TOPGEN]) == tg, bar);
            __builtin_amdgcn_fence(__ATOMIC_ACQUIRE, "agent");
            xb_add(&bar[XB_XGEN(b.x)], 1u);
            asm volatile("s_waitcnt vmcnt(0)" ::: "memory");
        } else {
            XB_SPIN(xb_ld(&bar[XB_XGEN(b.x)]) == gen, bar);
            __builtin_amdgcn_fence(__ATOMIC_ACQUIRE, "agent");
            asm volatile("s_waitcnt vmcnt(0)" ::: "memory");
        }
    }
    __syncthreads();
}

constexpr int NWAVES = 8;
#ifndef MK_N_LAUNCHES
#define MK_N_LAUNCHES 1
#endif
constexpr int N_PHASES = 26;
constexpr int N_LAUNCHES = MK_N_LAUNCHES;

constexpr int TP = 16384, TS = 1024, TT = TP + TS;
constexpr int DM = 1024, DA = 384, DB = 384, DC = 256, DFF = 2816, DPLE = 256, NL = 4, DIN = 2432;
constexpr int ZN = 2560, ZLD = 1792;
constexpr int Z_CA = 0, Z_GLU = 384, Z_GB = 640, Z_U = 1024, Z_V = 1408;
constexpr int GUN = 2 * DFF;
constexpr float EPS = 1e-6f;
constexpr size_t O_Y = 0, O_NAP = 17825792, O_NAS = 17850368, O_NCP = 18243584, O_NCS = 18489344, O_NVP = 22421504, O_NVS = 23994368, O_END = 25567232;
constexpr size_t MiB = 1u << 20;
constexpr size_t WS_CTL = 0, CTL_ZERO_BYTES = 1 * MiB;
constexpr size_t WS_SS = 345 * MiB, SS_STRIDE = (size_t)17408 * 16;
constexpr size_t WS_WIN = 2 * MiB, WS_WOUT = 22 * MiB, WS_WGU = 30 * MiB, WS_WDN = 74 * MiB, WS_WPG = 96 * MiB, WS_WPP = 104 * MiB;
constexpr size_t WS_HB0 = 106 * MiB, WS_HB1 = 140 * MiB, WS_MIX = 174 * MiB, WS_PROJ = 208 * MiB, WS_PB = 242 * MiB, WS_ZACT = 251 * MiB, WS_END = 349 * MiB;
static_assert(3 * SS_STRIDE * 4 <= 4 * MiB && (size_t)NL * ZN * DM * 2 == 20 * MiB && (size_t)NL * GUN * DM * 2 == 44 * MiB && (size_t)TT * DM * 2 == 34 * MiB && (size_t)TT * DFF * 2 <= 94 * MiB && (size_t)TT * DPLE * 2 <= 9 * MiB, "d_ws map");
constexpr int CW_TMO = 0, CW_CODE = 1, CW_BAR = 4096;

constexpr int RING_OFF = 0, RING_BYTES = 131072;
constexpr int LDSCTL_OFF = RING_BYTES, MISC_OFF = LDSCTL_OFF + 320;
constexpr int LDS_BYTES = 147456;

struct Args { const float* in[29]; float* out; unsigned char* ws; int ph_lo, ph_hi; };
typedef unsigned u32x2 __attribute__((ext_vector_type(2)));
typedef short v4i16_t __attribute__((ext_vector_type(4)));

struct Frame {
    LAS unsigned char* lds;
    volatile LAS unsigned* MISC;
    gu32* ctl;
    int tid, lane, wave, G;
    float* out; unsigned char* ws;
};

__device__ __forceinline__ float wave_sum(float v) {
#pragma unroll
    for (int o = 1; o < 64; o <<= 1) v += __shfl_xor(v, o);
    return v;
}
__device__ __forceinline__ unsigned pk_bf16(float lo, float hi) { return pg8::cvt_pk_bf16(lo, hi); }
__device__ __forceinline__ f32x4 up4(u32x2 w) { return (f32x4){pg8::bf_lo(w.x), pg8::bf_hi(w.x), pg8::bf_lo(w.y), pg8::bf_hi(w.y)}; }
__device__ __forceinline__ u32x2 pk4(f32x4 v) { u32x2 w; w.x = pk_bf16(v[0], v[1]); w.y = pk_bf16(v[2], v[3]); return w; }

__device__ __forceinline__ void p0_transpose_item(const float* W, int K, int N, bf16* WT, int dst_row0, const float* gain, LAS float* scr, int k0, int n0, int lane) {
#pragma unroll 8
    for (int i = 0; i < 32; ++i) { const int kk = 2 * i + (lane >> 5); float w = W[(size_t)(k0 + kk) * N + n0 + (lane & 31)]; if (gain) w *= gain[k0 + kk]; scr[kk * 33 + (lane & 31)] = w; }
    LDS_WAIT(); asm volatile("" ::: "memory");
    const int c = lane & 7;
#pragma unroll
    for (int j = 0; j < 4; ++j) { const int n = (lane >> 3) + 8 * j; const LAS float* s = scr + (8 * c) * 33 + n;
        v4u o; o.x = pk_bf16(s[0 * 33], s[1 * 33]); o.y = pk_bf16(s[2 * 33], s[3 * 33]); o.z = pk_bf16(s[4 * 33], s[5 * 33]); o.w = pk_bf16(s[6 * 33], s[7 * 33]);
        *(GAS v4u*)(WT + (size_t)(dst_row0 + n) * K + k0 + 8 * c) = o; }
    LDS_WAIT(); asm volatile("" ::: "memory");
}
__device__ __forceinline__ void convert_p(const Frame& F, const Args& A, int l, int gw, int ngw) {
    bf16* PB = (bf16*)(F.ws + WS_PB);
    for (int r = gw; r < TT; r += ngw) {
        const float* src = (r < TP) ? A.in[4] + ((size_t)l * TP + r) * DPLE : A.in[5] + ((size_t)l * TS + (r - TP)) * DPLE;
        const f32x4 v = *(const f32x4*)(src + 4 * F.lane);
        *(u32x2*)(PB + (size_t)r * DPLE + 4 * F.lane) = pk4(v);
    }
}
__device__ __forceinline__ void p0_prologue(const Frame& F, const Args& A) {
    LAS float* scr = (LAS float*)(F.lds + RING_OFF + F.wave * 16384);
    const int gw = blockIdx.x * NWAVES + F.wave, NGW = F.G * NWAVES;
    constexpr int I_IN = 16 * 76, I_OUT = 16 * 32, I_G = 16 * 88, I_DN = 44 * 32, I_PG = 16 * 32, I_PP = 4 * 32;
    constexpr int I_LAYER = I_IN + I_OUT + 2 * I_G + I_DN + I_PG + I_PP;
    for (int it = gw; it < NL * I_LAYER; it += NGW) {
        const int l = it / I_LAYER; int r = it % I_LAYER;
        if (r < I_IN) { const int kb = r / 76, nb = r % 76, n0 = 32 * nb, sb = n0 >> 7;
            const int kd = sb < 3 ? 2 * sb : sb < 6 ? sb + 7 : sb < 9 ? 2 * sb - 11 : sb < 15 ? sb + 4 : sb < 17 ? 2 * sb - 24 : 2 * sb - 27;
            p0_transpose_item(A.in[7] + (size_t)l * DM * DIN, DM, DIN, (bf16*)(F.ws + WS_WIN) + (size_t)l * ZN * DM, kd * 128 + (n0 & 127), A.in[6] + l * DM, scr, 64 * kb, n0, F.lane); continue; } r -= I_IN;
        if (r < I_OUT) { const int kb = r / 32, nb = r % 32, k0 = 64 * kb;
            const float* g = k0 < DA ? A.in[17] + l * DA : k0 < DA + DB ? A.in[18] + l * DB - DA : A.in[19] + l * DC - (DA + DB);
            p0_transpose_item(A.in[20] + (size_t)l * DM * DM, DM, DM, (bf16*)(F.ws + WS_WOUT) + (size_t)l * DM * DM, 32 * nb, g, scr, k0, 32 * nb, F.lane); continue; } r -= I_OUT;
        if (r < 2 * I_G) { const int up = r >= I_G; if (up) r -= I_G; const int kb = r / 88, nb = r % 88, n0 = 32 * nb;
            p0_transpose_item((up ? A.in[23] : A.in[22]) + (size_t)l * DM * DFF, DM, DFF, (bf16*)(F.ws + WS_WGU) + (size_t)l * GUN * DM, (n0 >> 7) * 256 + up * 128 + (n0 & 127), A.in[21] + l * DM, scr, 64 * kb, n0, F.lane); continue; } r -= 2 * I_G;
        if (r < I_DN) { const int kb = r / 32, nb = r % 32;
            p0_transpose_item(A.in[24] + (size_t)l * DFF * DM, DFF, DM, (bf16*)(F.ws + WS_WDN) + (size_t)l * DM * DFF, 32 * nb, nullptr, scr, 64 * kb, 32 * nb, F.lane); continue; } r -= I_DN;
        if (r < I_PG) { const int kb = r / 32, nb = r % 32;
            p0_transpose_item(A.in[26] + (size_t)l * DM * DM, DM, DM, (bf16*)(F.ws + WS_WPG) + (size_t)l * DM * DM, 32 * nb, A.in[25] + l * DM, scr, 64 * kb, 32 * nb, F.lane); continue; } r -= I_PG;
        { const int kb = r / 32, nb = r % 32;
            p0_transpose_item(A.in[27] + (size_t)l * DPLE * DM, DPLE, DM, (bf16*)(F.ws + WS_WPP) + (size_t)l * DM * DPLE, 32 * nb, nullptr, scr, 64 * kb, 32 * nb, F.lane); }
    }
    bf16* HB0 = (bf16*)(F.ws + WS_HB0); float* ss0 = (float*)(F.ws + WS_SS);
    for (int m = gw; m < TT; m += NGW) {
        const float* xr = (m < TP) ? A.in[0] + (size_t)m * DM : A.in[1] + (size_t)(m - TP) * DM;
        float s = 0.f;
#pragma unroll
        for (int j = 0; j < 4; ++j) { const f32x4 v = *(const f32x4*)(xr + 256 * j + 4 * F.lane); s += pg8::sumsq4(v); *(u32x2*)(HB0 + (size_t)m * DM + 256 * j + 4 * F.lane) = pk4(v); }
        s = wave_sum(s); if (F.lane < 16) ss0[(size_t)m * 16 + F.lane] = (F.lane == 0) ? s : 0.f;
    }
    convert_p(F, A, 0, gw, NGW);
}

__device__ __forceinline__ void mix_a(const Frame& F, const Args& A, int l, int c) {
    const bf16* ZB = (const bf16*)(F.ws + WS_ZACT); bf16* MIX = (bf16*)(F.ws + WS_MIX);
    int tid_ = F.tid; asm volatile("" : "+v"(tid_)); const int hw = tid_ >> 5, l32 = tid_ & 31; const int r0 = 128 * c + 8 * hw; const bool samp = (c >= 128);
    const float* cw = A.in[8] + (size_t)l * 3 * DA;
    f32x4 w0[3], w1[3], w2[3], p2[3], p1[3];
    const int q = samp ? (r0 - TP) >> 3 : 0;
#pragma unroll
    for (int i = 0; i < 3; ++i) { const int col = 4 * (l32 + 32 * i);
        w0[i] = *(const f32x4*)(cw + col); w1[i] = *(const f32x4*)(cw + DA + col); w2[i] = *(const f32x4*)(cw + 2 * DA + col);
        if (samp) { const float* st = A.in[2] + ((size_t)(l * 128 + q) * 2) * DA; p2[i] = *(const f32x4*)(st + col); p1[i] = *(const f32x4*)(st + DA + col); }
        else if (((c & 15) == 0) && hw == 0) { p2[i] = (f32x4){0.f, 0.f, 0.f, 0.f}; p1[i] = p2[i]; }
        else { p2[i] = up4(*(const u32x2*)(ZB + (size_t)(r0 - 2) * ZLD + Z_CA + col)); p1[i] = up4(*(const u32x2*)(ZB + (size_t)(r0 - 1) * ZLD + Z_CA + col)); } }
#pragma unroll 1
    for (int rr = 0; rr < 8; ++rr) { const int row = r0 + rr; f32x4 cur[3], y[3]; float s = 0.f;
#pragma unroll
        for (int i = 0; i < 3; ++i) { const int col = 4 * (l32 + 32 * i);
            cur[i] = up4(*(const u32x2*)(ZB + (size_t)row * ZLD + Z_CA + col)); const f32x4 gb = up4(*(const u32x2*)(ZB + (size_t)row * ZLD + Z_GB + col));
            y[i] = gb * (w0[i] * p2[i] + w1[i] * p1[i] + w2[i] * cur[i]); s += pg8::sumsq4(y[i]); }
#pragma unroll
        for (int o = 1; o < 32; o <<= 1) s += __shfl_xor(s, o);
        const float rs = rsqrtf(s * (1.0f / DA) + EPS);
#pragma unroll
        for (int i = 0; i < 3; ++i) { const int col = 4 * (l32 + 32 * i);
            *(u32x2*)(MIX + (size_t)row * DM + col) = pk4(y[i] * rs);
            if (rr >= 6) { if (samp) *(f32x4*)(F.out + O_NAS + ((size_t)(l * 128 + q) * 2 + (rr - 6)) * DA + col) = cur[i];
                           else if ((c & 15) == 15 && hw == 15) *(f32x4*)(F.out + O_NAP + ((size_t)(l * 8 + (c >> 4)) * 2 + (rr - 6)) * DA + col) = cur[i]; }
            p2[i] = p1[i]; p1[i] = cur[i]; }
    }
}
__device__ __forceinline__ void mix_c(const Frame& F, const Args& A, int l, int c) {
    const bf16* ZB = (const bf16*)(F.ws + WS_ZACT); bf16* MIX = (bf16*)(F.ws + WS_MIX);
    int lane_ = F.lane; asm volatile("" : "+v"(lane_));
    const bool samp = (c >= 128); const int col = 4 * lane_;
    const float* cw = A.in[13] + (size_t)l * 31 * DC + col;
    const f32x4 bias = *(const f32x4*)(A.in[14] + l * DC + col), lg = *(const f32x4*)(A.in[15] + l * DC + col), lb = *(const f32x4*)(A.in[16] + l * DC + col);
    const f32x4 zero4 = (f32x4){0.f, 0.f, 0.f, 0.f};
#pragma unroll 1
    for (int hb = 0; hb < 2; ++hb) {
        const int rb = 16 * F.wave + 8 * hb;
        const int q = samp ? 16 * (c - 128) + 2 * F.wave + hb : 0;
        const float* st = A.in[3] + ((size_t)(l * 128 + q) * 30) * DC + col;
        const bf16* zb = ZB + ((size_t)128 * c + rb) * ZLD + Z_GLU + col;
        const int t0 = 128 * (c & 15) + rb - 30;
        f32x4 acc[8];
#pragma unroll
        for (int o = 0; o < 8; ++o) acc[o] = zero4;
#pragma unroll 1
        for (int kb = 0; kb < 4; ++kb) {
            f32x4 xw[15];
#pragma unroll
            for (int j = 0; j < 15; ++j) { const int i = 8 * kb + j; f32x4 xi = zero4;
                if (i <= 37) { if (samp && i < 30) xi = *(const f32x4*)(st + (size_t)i * DC);
                               else if (samp || t0 + i >= 0) xi = up4(*(const u32x2*)(zb + ((ptrdiff_t)i - 30) * ZLD)); }
                xw[j] = xi; }
#pragma unroll
            for (int kk = 0; kk < 8; ++kk) { const int k = 8 * kb + kk; const f32x4 w = (k <= 30) ? *(const f32x4*)(cw + (size_t)k * DC) : zero4;
#pragma unroll
                for (int o = 0; o < 8; ++o) acc[o] += w * xw[o + kk]; }
        }
#pragma unroll
        for (int o = 0; o < 8; ++o) { const int row = 128 * c + rb + o;
            const f32x4 v = acc[o] + bias; const float mean = wave_sum((v[0] + v[1]) + (v[2] + v[3])) * (1.0f / DC);
            const f32x4 d = v - mean; const float rstd = rsqrtf(wave_sum(pg8::sumsq4(d)) * (1.0f / DC) + EPS);
            const f32x4 yn = d * rstd * lg + lb; const f32x4 y = yn * pg8::sigm4(yn);
            const float rs = rsqrtf(wave_sum(pg8::sumsq4(y)) * (1.0f / DC) + EPS);
            *(u32x2*)(MIX + (size_t)row * DM + DA + DB + col) = pk4(y * rs); }
        if (samp) { float* onc = F.out + O_NCS + ((size_t)(l * 128 + q) * 30) * DC + col;
#pragma unroll 2
            for (int i = 0; i < 22; ++i) *(f32x4*)(onc + (size_t)i * DC) = *(const f32x4*)(st + (size_t)(8 + i) * DC);
#pragma unroll 2
            for (int o = 0; o < 8; ++o) *(f32x4*)(onc + (size_t)(22 + o) * DC) = up4(*(const u32x2*)(zb + (size_t)o * ZLD)); }
        else if ((c & 15) == 15) { float* onc = F.out + O_NCP + ((size_t)(l * 8 + (c >> 4)) * 30) * DC + col;
#pragma unroll 2
            for (int o = 0; o < 8; ++o) if (rb + o >= 98) *(f32x4*)(onc + (size_t)(rb + o - 98) * DC) = up4(*(const u32x2*)(zb + (size_t)o * ZLD)); }
    }
}
__device__ __forceinline__ void mix_b(const Frame& F, const Args& A, int l, int c) {
    const bf16* ZB = (const bf16*)(F.ws + WS_ZACT); bf16* MIX = (bf16*)(F.ws + WS_MIX);
    constexpr int VS = 392;
    LAS bf16* vn = (LAS bf16*)(F.lds + RING_OFF);
    const bool samp = (c >= 128); int lane_ = F.lane; asm volatile("" : "+v"(lane_)); const int w = F.wave, lane = lane_;
    {
        const bool act = lane < 48; const int col = 8 * (act ? lane : 0);
        f32x4 g0 = *(const f32x4*)(A.in[9] + l * DB + col), g1 = *(const f32x4*)(A.in[9] + l * DB + col + 4), b0 = *(const f32x4*)(A.in[10] + l * DB + col), b1 = *(const f32x4*)(A.in[10] + l * DB + col + 4);
#pragma unroll 2
        for (int rr = 0; rr < 16; ++rr) { const int rowc = 16 * w + rr, row = 128 * c + rowc;
            const v4u pv = *(const v4u*)(ZB + (size_t)row * ZLD + Z_V + col);
            f32x4 v0 = (f32x4){pg8::bf_lo(pv.x), pg8::bf_hi(pv.x), pg8::bf_lo(pv.y), pg8::bf_hi(pv.y)}, v1 = (f32x4){pg8::bf_lo(pv.z), pg8::bf_hi(pv.z), pg8::bf_lo(pv.w), pg8::bf_hi(pv.w)};
            float s = (v0[0] + v0[1]) + (v0[2] + v0[3]) + (v1[0] + v1[1]) + (v1[2] + v1[3]); if (!act) s = 0.f;
            const float mean = wave_sum(s) * (1.0f / DB);
            v0 = v0 - mean; v1 = v1 - mean; float qv = pg8::sumsq4(v0) + pg8::sumsq4(v1); if (!act) qv = 0.f;
            const float rstd = rsqrtf(wave_sum(qv) * (1.0f / DB) + EPS);
            v0 = v0 * rstd * g0 + b0; v1 = v1 * rstd * g1 + b1;
            if (act) { v4u o; o.x = pk_bf16(v0[0], v0[1]); o.y = pk_bf16(v0[2], v0[3]); o.z = pk_bf16(v1[0], v1[1]); o.w = pk_bf16(v1[2], v1[3]);
                *(LAS v4u*)(vn + rowc * VS + col) = o;
                if (samp) { float* o7 = F.out + O_NVS + ((size_t)l * TS + (row - TP)) * DB + col; *(f32x4*)o7 = v0; *(f32x4*)(o7 + 4) = v1; }
                else if ((c & 15) == 15) { float* o6 = F.out + O_NVP + ((size_t)(l * 8 + (c >> 4)) * 128 + rowc) * DB + col; *(f32x4*)o6 = v0; *(f32x4*)(o6 + 4) = v1; } }
        }
    }
    __syncthreads();
    f32x4 acc[6][4];
#pragma unroll
    for (int h = 0; h < 6; ++h)
#pragma unroll
        for (int mt = 0; mt < 4; ++mt) acc[h][mt] = (f32x4){0.f, 0.f, 0.f, 0.f};
    const int t = 16 * w + (lane & 15), g = lane >> 4, q4 = (lane & 15) >> 2, p = lane & 3;
    const int ks_lo = samp ? (w >> 1) : 0, ks_hi = w >> 1;
    const int tp = samp ? (t & 7) : t;
    const bool bvalid = samp ? (g == 2 * (w & 1) + ((lane & 15) >> 3)) : true;
#pragma unroll 1
    for (int ks = ks_lo; ks <= ks_hi; ++ks) {
        const int s0 = samp ? 0 : 32 * ks + 8 * g;
#pragma unroll
        for (int h = 0; h < 6; ++h) {
            const float* wp = A.in[11] + ((size_t)(l * 6 + h) * 128 + tp) * 128 + s0;
            const f32x4 a = *(const f32x4*)wp, b = *(const f32x4*)(wp + 4);
            float wv[8] = {a[0], a[1], a[2], a[3], b[0], b[1], b[2], b[3]};
#pragma unroll
            for (int j = 0; j < 8; ++j) wv[j] = (bvalid && (s0 + j <= tp)) ? wv[j] : 0.f;
            bf16x8 bfrag; { v4u o; o.x = pk_bf16(wv[0], wv[1]); o.y = pk_bf16(wv[2], wv[3]); o.z = pk_bf16(wv[4], wv[5]); o.w = pk_bf16(wv[6], wv[7]); bfrag = __builtin_bit_cast(bf16x8, o); }
#pragma unroll
            for (int mt = 0; mt < 4; ++mt) { const int d0 = 64 * h + 16 * mt;
                const LAS bf16* ap = vn + (32 * ks + 8 * g + q4) * VS + d0 + 4 * p;
                const v4i16_t lo = __builtin_amdgcn_ds_read_tr16_b64_v4i16((LAS v4i16_t*)ap), hi = __builtin_amdgcn_ds_read_tr16_b64_v4i16((LAS v4i16_t*)(ap + 4 * VS));
                bf16x8 afrag; afrag[0] = lo[0]; afrag[1] = lo[1]; afrag[2] = lo[2]; afrag[3] = lo[3]; afrag[4] = hi[0]; afrag[5] = hi[1]; afrag[6] = hi[2]; afrag[7] = hi[3];
                acc[h][mt] = __builtin_amdgcn_mfma_f32_16x16x32_bf16(afrag, bfrag, acc[h][mt], 0, 0, 0); }
        }
    }
    const int row = 128 * c + t; float qs = 0.f;
#pragma unroll
    for (int h = 0; h < 6; ++h) { const float bs = A.in[12][(size_t)(l * 6 + h) * 128 + tp];
#pragma unroll
        for (int mt = 0; mt < 4; ++mt) { const int col = 64 * h + 16 * mt + 4 * g;
            const f32x4 u4 = up4(*(const u32x2*)(ZB + (size_t)row * ZLD + Z_U + col)); acc[h][mt] = u4 * (acc[h][mt] + bs); qs += pg8::sumsq4(acc[h][mt]); } }
    qs += __shfl_xor(qs, 16); qs += __shfl_xor(qs, 32);
    const float rs = rsqrtf(qs * (1.0f / DB) + EPS);
#pragma unroll
    for (int h = 0; h < 6; ++h)
#pragma unroll
        for (int mt = 0; mt < 4; ++mt) *(u32x2*)(MIX + (size_t)row * DM + DA + 64 * h + 16 * mt + 4 * g) = pk4(acc[h][mt] * rs);
    __syncthreads();
}
__device__ __forceinline__ void mixer_phase(const Frame& F, const Args& A, int l) {
    for (int u = blockIdx.x; u < 3 * 136; u += F.G) {
        if (u < 136) mix_b(F, A, l, u); else if (u < 272) mix_c(F, A, l, u - 136); else mix_a(F, A, l, u - 272);
    }
    if (l + 1 < NL) convert_p(F, A, l + 1, blockIdx.x * NWAVES + F.wave, F.G * NWAVES);
}
__device__ __forceinline__ void final_phase(const Frame& F, const Args& A) {
    const float* ss = (const float*)(F.ws + WS_SS);
    for (int m = blockIdx.x * NWAVES + F.wave; m < TT; m += F.G * NWAVES) {
        const float rs = rsqrtf(pg8::row_ss(ss, m) * (1.0f / DM) + EPS); float* hr = F.out + (size_t)m * DM;
#pragma unroll
        for (int j = 0; j < 4; ++j) { const int col = 256 * j + 4 * F.lane; const f32x4 v = *(const f32x4*)(hr + col), gg = *(const f32x4*)(A.in[28] + col); *(f32x4*)(hr + col) = v * rs * gg; }
    }
}

__global__ void __launch_bounds__(NWAVES * 64, 2) mk_fwd(Args args) {
    extern __shared__ __attribute__((aligned(16))) unsigned char lds[];
    Frame F;
    F.lds = (LAS unsigned char*)lds; F.MISC = (volatile LAS unsigned*)(F.lds + MISC_OFF);
    F.tid = threadIdx.x; F.lane = F.tid & 63; F.wave = __builtin_amdgcn_readfirstlane(F.tid >> 6); F.G = gridDim.x;
    F.out = args.out; F.ws = args.ws; F.ctl = (gu32*)(args.ws + WS_CTL);
    for (int u = F.tid; u < (LDS_BYTES - LDSCTL_OFF) / 4; u += NWAVES * 64) ((LAS unsigned*)(F.lds + LDSCTL_OFF))[u] = 0u;
    __syncthreads();
    XcdBarrier bar; bar.bar = (unsigned*)(F.ctl + CW_BAR); bar.x = 0; bar.st = nullptr;
    if (N_LAUNCHES == 1) bar = xcd_barrier_post((unsigned*)(F.ctl + CW_BAR), F.MISC + 8);
    const int lo = args.ph_lo, hi = args.ph_hi;
#define IN(k) (lo <= (k) && (k) < hi)
#define SEAM(k) do { if (IN(k) && IN((k) + 1)) xcd_barrier(bar); } while (0)
    float* ssb = (float*)(args.ws + WS_SS);
    bf16* ZB = (bf16*)(args.ws + WS_ZACT); bf16* ACT = ZB; bf16* MIX = (bf16*)(args.ws + WS_MIX); bf16* PROJ = (bf16*)(args.ws + WS_PROJ); bf16* PB = (bf16*)(args.ws + WS_PB);

    if (IN(0)) { p0_prologue(F, args); } SEAM(0);
#pragma unroll 1
    for (int l = 0; l < NL; ++l) {
        const int pb = 1 + 6 * l; bf16* hcur = (bf16*)(args.ws + ((l & 1) ? WS_HB1 : WS_HB0)); bf16* hnxt = (bf16*)(args.ws + ((l & 1) ? WS_HB0 : WS_HB1));
        float* ssA = ssb; float* ssB = ssb + SS_STRIDE; float* ssC = ssb + 2 * SS_STRIDE; float* ssA2 = ssA;
        if (IN(pb)) {
            { pg8::Gemm g{hcur, (bf16*)(args.ws + WS_WIN) + (size_t)l * ZN * DM, TT, ZN, DM}; pg8::StaticOrder S; S.init(TT, ZN, F.G, (int)blockIdx.x);
              pg8::EpiZ E{ZB, ssA, ZLD}; pg8::gemm_phase<pg8::EpiZ, pg8::StaticOrder, true, true>(F.lds + RING_OFF, g, S, E); }
            { pg8::Gemm g{PB, (bf16*)(args.ws + WS_WPP) + (size_t)l * DM * DPLE, TT, DM, DPLE}; pg8::StaticOrder S; S.init(TT, DM, F.G, F.G == 256 ? (int)((blockIdx.x + 88u) & 255u) : (int)blockIdx.x);
              pg8::EpiPlain E{PROJ, DM}; pg8::gemm_phase<pg8::EpiPlain, pg8::StaticOrder, true, true>(F.lds + RING_OFF, g, S, E); }
        } SEAM(pb);
        if (IN(pb + 1)) { mixer_phase(F, args, l); } SEAM(pb + 1);
        if (IN(pb + 2)) {
            pg8::Gemm g{MIX, (bf16*)(args.ws + WS_WOUT) + (size_t)l * DM * DM, TT, DM, DM}; pg8::StaticOrder S; S.init(TT, DM, F.G, (int)blockIdx.x);
            pg8::EpiRes E{l == 0 ? args.in[0] : F.out, l == 0 ? args.in[1] : F.out + (size_t)TP * DM, F.out, hnxt, ssB};
            pg8::gemm_phase<pg8::EpiRes, pg8::StaticOrder, true, true>(F.lds + RING_OFF, g, S, E);
        } SEAM(pb + 2);
        if (IN(pb + 3)) {
            pg8::Gemm g{hnxt, (bf16*)(args.ws + WS_WGU) + (size_t)l * GUN * DM, TT, GUN, DM}; pg8::StaticOrder S; S.init(TT, GUN, F.G, (int)blockIdx.x);
            pg8::EpiGU E{ACT, ssB, DFF}; pg8::gemm_phase<pg8::EpiGU, pg8::StaticOrder, true, true>(F.lds + RING_OFF, g, S, E);
        } SEAM(pb + 3);
        if (IN(pb + 4)) {
            pg8::Gemm g{ACT, (bf16*)(args.ws + WS_WDN) + (size_t)l * DM * DFF, TT, DM, DFF}; pg8::StaticOrder S; S.init(TT, DM, F.G, (int)blockIdx.x);
            pg8::EpiRes E{F.out, F.out + (size_t)TP * DM, F.out, hcur, ssC}; pg8::gemm_phase<pg8::EpiRes, pg8::StaticOrder, true, true>(F.lds + RING_OFF, g, S, E);
        } SEAM(pb + 4);
        if (IN(pb + 5)) {
            pg8::Gemm g{hcur, (bf16*)(args.ws + WS_WPG) + (size_t)l * DM * DM, TT, DM, DM}; pg8::StaticOrder S; S.init(TT, DM, F.G, (int)blockIdx.x);
            pg8::EpiPle E{F.out, hnxt, PROJ, ssC, ssA2}; pg8::gemm_phase<pg8::EpiPle, pg8::StaticOrder, true, true>(F.lds + RING_OFF, g, S, E);
        } SEAM(pb + 5);
    }
    if (IN(25)) final_phase(F, args);
#undef IN
#undef SEAM
}

extern "C" void kernel_launch(void* const* d_in, const int* in_sizes, int n_in, void* d_out, int out_size, void* d_ws, size_t ws_size, hipStream_t stream) {
    static int grid = 0;
    if (grid == 0) {
        if (n_in != 29 || in_sizes[0] != TP * DM || (size_t)out_size != O_END || ws_size < WS_END) { fprintf(stderr, "kernel_launch: unexpected shapes: n_in %d in0 %d out %d ws %zu (need %zu)\n", n_in, n_in > 0 ? in_sizes[0] : -1, out_size, ws_size, (size_t)WS_END); grid = -1; return; }
        int dev = 0, cus = 0, per_cu = 0;
        if (hipGetDevice(&dev) != hipSuccess || hipDeviceGetAttribute(&cus, hipDeviceAttributeMultiprocessorCount, dev) != hipSuccess) { grid = -1; return; }
        if (hipFuncSetAttribute((const void*)mk_fwd, hipFuncAttributeMaxDynamicSharedMemorySize, LDS_BYTES) != hipSuccess) { fprintf(stderr, "kernel_launch: hipFuncSetAttribute failed\n"); grid = -1; return; }
        if (hipOccupancyMaxActiveBlocksPerMultiprocessor(&per_cu, (const void*)mk_fwd, NWAVES * 64, LDS_BYTES) != hipSuccess || per_cu < 1) fprintf(stderr, "kernel_launch: occupancy query reports %d blocks per CU\n", per_cu);
        (void)hipGetLastError();
        grid = cus;
        if (grid != 256) fprintf(stderr, "kernel_launch: %d CUs (tuned for 256)\n", grid);
    }
    if (grid < 0) return;
    if (hipMemsetAsync((char*)d_ws + WS_CTL, 0, CTL_ZERO_BYTES, stream) != hipSuccess) { fprintf(stderr, "kernel_launch: memset failed\n"); return; }
    Args a{};
    for (int i = 0; i < 29; ++i) a.in[i] = (const float*)d_in[i];
    a.out = (float*)d_out; a.ws = (unsigned char*)d_ws;
    if (N_LAUNCHES == 1) { a.ph_lo = 0; a.ph_hi = N_PHASES; hipLaunchKernelGGL(mk_fwd, dim3(grid), dim3(NWAVES * 64), LDS_BYTES, stream, a); }
    else for (int p = 0; p < N_PHASES; ++p) { a.ph_lo = p; a.ph_hi = p + 1; hipLaunchKernelGGL(mk_fwd, dim3(grid), dim3(NWAVES * 64), LDS_BYTES, stream, a); }
}
```

```cpp
#include <hip/hip_runtime.h>
#include <cstdio>
#include <cstdint>
namespace pg8 {
#define PG8_LAS __attribute__((address_space(3)))
typedef unsigned short bf16_t;
typedef short bf16x8 __attribute__((ext_vector_type(8)));
typedef float f32x4 __attribute__((ext_vector_type(4)));
typedef unsigned u32x4 __attribute__((ext_vector_type(4)));
constexpr int BM = 256, BK = 64, HALF = 128, HTB = HALF * BK * 2  , STAGE_BYTES = 8 * HTB, NXCD = 8, WGM = 8;

__host__ __device__ __forceinline__ int lds_byte(int r, int c) { const int st = (r >> 4) * 2 + (c >> 5), rr = r & 15, cc = c & 31, ob = rr * 64 + cc * 2; return st * 1024 + (ob ^ (((ob >> 9) & 1) << 5)); }
__host__ __device__ __forceinline__ void stage_rc(int b, int& R, int& C) { const int st = b / 1024, sb = b % 1024, swz = sb ^ (((sb >> 9) & 1) << 5); R = (st >> 1) * 16 + swz / 64; C = (st & 1) * 32 + (swz % 64) / 2; }
__host__ __device__ __forceinline__ int perm32(int rho) { const int n = rho >> 4, i = rho & 15; return 8 * (i >> 2) + 4 * n + (i & 3); }

struct Unit { int pm, pn; };
struct Gemm { const bf16_t* A; const bf16_t* Bt; int M, N, K; };

struct StaticOrder {
    int nM, nN, nwg, G, c;
    __host__ __device__ void init(int M, int N, int G_, int c_) { nM = M / BM; nN = N / BM; nwg = nM * nN; G = G_; c = c_; }
    __host__ __device__ bool next(int i, Unit& u) const {
        const long L = (long)i * G + c; if (L >= nwg) return false;
        int wgid = (int)L; { const int q = nwg / NXCD, r = nwg % NXCD, xcd = wgid % NXCD, off = wgid / NXCD; wgid = (xcd < r ? xcd * (q + 1) : r * (q + 1) + (xcd - r) * q) + off; }
        const int nig = WGM * nN, gid = wgid / nig, fm = gid * WGM, gsz = (nM - fm) < WGM ? (nM - fm) : WGM;
        u.pm = fm + ((wgid % nig) % gsz); u.pn = (wgid % nig) / gsz; return true;
    }
    __device__ __forceinline__ void a_ready(const Unit&) const {}
    __device__ __forceinline__ void done(const Unit&) const {}
};

__device__ __forceinline__ unsigned cvt_pk_bf16(float lo, float hi) { unsigned r; asm volatile("v_cvt_pk_bf16_f32 %0, %1, %2" : "=v"(r) : "v"(lo), "v"(hi)); return r; }
typedef float f32x2 __attribute__((ext_vector_type(2)));
__device__ __forceinline__ f32x2 gelu_pk(f32x2 v) {
    const f32x2 av = __builtin_elementwise_abs(v), d = av * 0.2316418882f + 1.0f;
    f32x2 t; t.x = __builtin_amdgcn_rcpf(d.x); t.y = __builtin_amdgcn_rcpf(d.y);
    f32x2 q = t * 0.5307027145f + (-0.7265760135f); q = q * t + 0.7107068705f; q = q * t + (-0.142248368f); q = q * t + 0.127414796f; q = q * t;
    const f32x2 s = (v * v) * (-0.72134752044f);
    f32x2 e; e.x = __builtin_amdgcn_exp2f(s.x); e.y = __builtin_amdgcn_exp2f(s.y);
    const f32x2 m = v * (q * e), r = v - m;
    f32x2 o; o.x = v.x < 0.f ? m.x : r.x; o.y = v.y < 0.f ? m.y : r.y; return o;
}

constexpr int TP_ROWS = 16384;
constexpr float RMS_EPS = 1e-6f;
__device__ __forceinline__ float sigm(float x) { return __builtin_amdgcn_rcpf(1.0f + __builtin_amdgcn_exp2f(-1.44269504089f * x)); }
__device__ __forceinline__ f32x4 sigm4(f32x4 x) { return (f32x4){sigm(x[0]), sigm(x[1]), sigm(x[2]), sigm(x[3])}; }
__device__ __forceinline__ f32x4 gelu4(f32x4 x) { const f32x2 a = gelu_pk((f32x2){x[0], x[1]}), b = gelu_pk((f32x2){x[2], x[3]}); return (f32x4){a.x, a.y, b.x, b.y}; }
__device__ __forceinline__ void st_bf16x8(bf16_t* p, f32x4 v0, f32x4 v1) { u32x4 w; w.x = cvt_pk_bf16(v0[0], v0[1]); w.y = cvt_pk_bf16(v0[2], v0[3]); w.z = cvt_pk_bf16(v1[0], v1[1]); w.w = cvt_pk_bf16(v1[2], v1[3]); *(u32x4*)p = w; }
__device__ __forceinline__ float bf_lo(unsigned w) { return __uint_as_float(w << 16); }
__device__ __forceinline__ float bf_hi(unsigned w) { return __uint_as_float(w & 0xffff0000u); }
__device__ __forceinline__ float sumsq4(f32x4 v) { return (v[0] * v[0] + v[1] * v[1]) + (v[2] * v[2] + v[3] * v[3]); }
__device__ __forceinline__ float row_ss(const float* ssp, int row) { const f32x4* p = (const f32x4*)(ssp + (size_t)row * 16); const f32x4 a = p[0], b = p[1], c = p[2], d = p[3];
    return (((a[0] + a[1]) + (a[2] + a[3])) + ((b[0] + b[1]) + (b[2] + b[3]))) + (((c[0] + c[1]) + (c[2] + c[3])) + ((d[0] + d[1]) + (d[2] + d[3]))); }

struct EpiZ {
    static constexpr bool PERM = true, AFTER_DRAIN = false;
    bf16_t* Z; const float* ss; int zld;
    __device__ __forceinline__ void operator()(const f32x4 (&acc)[2][2][4][2], const Unit& u, int wr, int wc, int fr, int fq) const {
        const int row0 = u.pm * BM + wr * 64 + fr, cl = wc * 32 + 8 * fq, pn = u.pn;
#pragma unroll
        for (int ai = 0; ai < 2; ++ai)
#pragma unroll
            for (int m = 0; m < 4; ++m) {
                const int row = row0 + ai * HALF + m * 16; const float rs = rsqrtf(row_ss(ss, row) * (1.0f / 1024.0f) + RMS_EPS); bf16_t* zr = Z + (size_t)row * zld;
                if (pn < 3) { const f32x4 v0 = (acc[ai][0][m][0] * rs) * (acc[ai][1][m][0] * rs), v1 = (acc[ai][0][m][1] * rs) * (acc[ai][1][m][1] * rs); st_bf16x8(zr + 128 * pn + cl, v0, v1); }
                else if (pn < 5) { const f32x4 v0 = (acc[ai][0][m][0] * rs) * sigm4(acc[ai][1][m][0] * rs), v1 = (acc[ai][0][m][1] * rs) * sigm4(acc[ai][1][m][1] * rs); st_bf16x8(zr + 384 + 128 * (pn - 3) + cl, v0, v1); }
                else {
#pragma unroll
                    for (int bj = 0; bj < 2; ++bj) { const int kb = 2 * pn + bj; if (kb < 19) { f32x4 v0 = acc[ai][bj][m][0] * rs, v1 = acc[ai][bj][m][1] * rs; if (kb >= 13) { v0 = gelu4(v0); v1 = gelu4(v1); } st_bf16x8(zr + 640 + (kb - 10) * 128 + cl, v0, v1); } }
                }
            }
    }
};
struct EpiPlain {
    static constexpr bool PERM = true, AFTER_DRAIN = false;
    bf16_t* O; int ldc;
    __device__ __forceinline__ void operator()(const f32x4 (&acc)[2][2][4][2], const Unit& u, int wr, int wc, int fr, int fq) const {
        const int row0 = u.pm * BM + wr * 64 + fr, col0 = u.pn * BM + wc * 32 + 8 * fq;
#pragma unroll
        for (int ai = 0; ai < 2; ++ai)
#pragma unroll
            for (int m = 0; m < 4; ++m) { bf16_t* rowp = O + (size_t)(row0 + ai * HALF + m * 16) * ldc + col0;
#pragma unroll
                for (int bj = 0; bj < 2; ++bj) st_bf16x8(rowp + bj * HALF, acc[ai][bj][m][0], acc[ai][bj][m][1]); }
    }
};
struct EpiRes {
    static constexpr bool PERM = true, AFTER_DRAIN = false;
    const float* hin_p; const float* hin_s; float* hout; bf16_t* hb; float* ssq; float scale;
    __device__ __forceinline__ void operator()(const f32x4 (&acc)[2][2][4][2], const Unit& u, int wr, int wc, int fr, int fq) const {
        const int row0 = u.pm * BM + wr * 64 + fr, col0 = u.pn * BM + wc * 32 + 8 * fq;
        const bool isp = (u.pm * BM < TP_ROWS); const float* hin = isp ? hin_p : hin_s; const int rsub = isp ? 0 : TP_ROWS;
#pragma unroll
        for (int ai = 0; ai < 2; ++ai)
#pragma unroll
            for (int m = 0; m < 4; ++m) { const int row = row0 + ai * HALF + m * 16; const size_t off = (size_t)row * 1024 + col0, offi = (size_t)(row - rsub) * 1024 + col0; float q = 0.f;
#pragma unroll
                for (int bj = 0; bj < 2; ++bj) { const f32x4 a0 = *(const f32x4*)(hin + offi + bj * HALF), a1 = *(const f32x4*)(hin + offi + bj * HALF + 4);
                    const f32x4 v0 = a0 + acc[ai][bj][m][0] * scale, v1 = a1 + acc[ai][bj][m][1] * scale;
                    *(f32x4*)(hout + off + bj * HALF) = v0; *(f32x4*)(hout + off + bj * HALF + 4) = v1; st_bf16x8(hb + off + bj * HALF, v0, v1); q += sumsq4(v0) + sumsq4(v1); }
                q += __shfl_xor(q, 16); q += __shfl_xor(q, 32);
                if (fq == 0) ssq[(size_t)row * 16 + 4 * u.pn + wc] = q; }
    }
};
struct EpiGU {
    static constexpr bool PERM = true, AFTER_DRAIN = false;
    bf16_t* O; const float* ss; int ldc;
    __device__ __forceinline__ void operator()(const f32x4 (&acc)[2][2][4][2], const Unit& u, int wr, int wc, int fr, int fq) const {
        const int row0 = u.pm * BM + wr * 64 + fr, col0 = u.pn * HALF + wc * 32 + 8 * fq;
#pragma unroll
        for (int ai = 0; ai < 2; ++ai)
#pragma unroll
            for (int m = 0; m < 4; ++m) { const int row = row0 + ai * HALF + m * 16; const float rs = rsqrtf(row_ss(ss, row) * (1.0f / 1024.0f) + RMS_EPS);
                const f32x4 g0 = acc[ai][0][m][0] * rs, g1 = acc[ai][0][m][1] * rs, u0 = acc[ai][1][m][0] * rs, u1 = acc[ai][1][m][1] * rs;
                st_bf16x8(O + (size_t)row * ldc + col0, g0 * sigm4(g0) * u0, g1 * sigm4(g1) * u1); }
    }
};
struct EpiPle {
    static constexpr bool PERM = true, AFTER_DRAIN = false;
    float* h; bf16_t* hb; const bf16_t* proj; const float* ss; float* ssq; float scale;
    __device__ __forceinline__ void operator()(const f32x4 (&acc)[2][2][4][2], const Unit& u, int wr, int wc, int fr, int fq) const {
        const int row0 = u.pm * BM + wr * 64 + fr, col0 = u.pn * BM + wc * 32 + 8 * fq;
#pragma unroll
        for (int ai = 0; ai < 2; ++ai)
#pragma unroll
            for (int m = 0; m < 4; ++m) { const int row = row0 + ai * HALF + m * 16; const size_t off = (size_t)row * 1024 + col0; float q = 0.f;
                const float rs = rsqrtf(row_ss(ss, row) * (1.0f / 1024.0f) + RMS_EPS);
#pragma unroll
                for (int bj = 0; bj < 2; ++bj) { const f32x4 a0 = *(const f32x4*)(h + off + bj * HALF), a1 = *(const f32x4*)(h + off + bj * HALF + 4);
                    const u32x4 pw = *(const u32x4*)(proj + off + bj * HALF);
                    const f32x4 p0 = (f32x4){bf_lo(pw.x), bf_hi(pw.x), bf_lo(pw.y), bf_hi(pw.y)}, p1 = (f32x4){bf_lo(pw.z), bf_hi(pw.z), bf_lo(pw.w), bf_hi(pw.w)};
                    const f32x4 v0 = a0 + sigm4(acc[ai][bj][m][0] * rs) * (p0 * scale), v1 = a1 + sigm4(acc[ai][bj][m][1] * rs) * (p1 * scale);
                    *(f32x4*)(h + off + bj * HALF) = v0; *(f32x4*)(h + off + bj * HALF + 4) = v1; st_bf16x8(hb + off + bj * HALF, v0, v1); q += sumsq4(v0) + sumsq4(v1); }
                q += __shfl_xor(q, 16); q += __shfl_xor(q, 32);
                if (fq == 0) ssq[(size_t)row * 16 + 4 * u.pn + wc] = q; }
    }
};
template <class Epi, class Sched, bool ALIGN_EPI = false, bool SP2 = false>
__device__ __forceinline__ void gemm_phase(PG8_LAS unsigned char* lds, const Gemm g, const Sched& S, const Epi& E) {
    int tid_ = threadIdx.x; asm volatile("" : "+v"(tid_));
    const int tid = tid_, wid = __builtin_amdgcn_readfirstlane(tid >> 6), lane = tid & 63, wr = wid >> 2, wc = wid & 3, fr = lane & 15, fq = lane >> 4;
    int K_ = g.K; asm volatile("" : "+s"(K_));
    const int K = K_, nt = K / BK;
    unsigned voffA[2], voffB[2];
#pragma unroll
    for (int i = 0; i < 2; ++i) { int R, C; stage_rc(tid * 16 + i * 8192, R, C); const int Rb = Epi::PERM ? ((R & ~31) + perm32(R & 31)) : R;
        voffA[i] = (unsigned)(R * K + C) * 2u; voffB[i] = (unsigned)(Rb * K + C) * 2u; }
    const size_t kstep = (size_t)(BK * 2);
    const size_t hstep = (size_t)HALF * K * 2;
    const size_t tstep = 2 * hstep;
    const unsigned ldsw = (unsigned)wid * 1024u;
    const int aoff = lds_byte(wr * 64 + fr, fq * 8), boff = lds_byte(wc * 32 + fr, fq * 8);
#define PG8_SA(b, h) (((b) * 2 + (h)) * HTB)
#define PG8_SB(b, h) ((4 + (b) * 2 + (h)) * HTB)
#define PG8_STAGE(bufoff, gbase, voff) do { _Pragma("unroll") for (int _i = 0; _i < 2; ++_i) \
        __builtin_amdgcn_global_load_lds((const unsigned*)((const char*)(gbase) + (voff)[_i]), (PG8_LAS unsigned*)(lds + (bufoff) + ldsw + _i * 8192), 16, 0, 0); } while (0)
#define PG8_LDA(dst, b, h) do { _Pragma("unroll") for (int m = 0; m < 4; ++m) _Pragma("unroll") for (int k = 0; k < 2; ++k) dst[m][k] = *(const PG8_LAS bf16x8*)(lds + PG8_SA(b, h) + aoff + m * 2048 + k * 1024); } while (0)
#define PG8_LDB(dst, b, h) do { _Pragma("unroll") for (int n = 0; n < 2; ++n) _Pragma("unroll") for (int k = 0; k < 2; ++k) dst[n][k] = *(const PG8_LAS bf16x8*)(lds + PG8_SB(b, h) + boff + n * 2048 + k * 1024); } while (0)
#define PG8_MMA(ai, bj, At, Bt) do { __builtin_amdgcn_s_setprio(1); _Pragma("unroll") for (int m = 0; m < 4; ++m) _Pragma("unroll") for (int n = 0; n < 2; ++n) _Pragma("unroll") for (int k = 0; k < 2; ++k) \
        acc[ai][bj][m][n] = __builtin_amdgcn_mfma_f32_16x16x32_bf16(Bt[n][k], At[m][k], acc[ai][bj][m][n], 0, 0, 0); __builtin_amdgcn_s_setprio(0); } while (0)
#define PG8_WAIT_V(n) asm volatile("s_waitcnt vmcnt(" #n ")" ::: "memory")
#define PG8_WAIT_L(n) asm volatile("s_waitcnt lgkmcnt(" #n ")" ::: "memory")
#define PG8_BAR __builtin_amdgcn_s_barrier()
#define PG8_SCHED __builtin_amdgcn_sched_barrier(0)
    Unit cur, nxt; int ui = 0;
    if (!S.next(0, cur)) return;
    f32x4 acc[2][2][4][2];
#pragma unroll
    for (int a = 0; a < 2; ++a)
#pragma unroll
        for (int b = 0; b < 2; ++b)
#pragma unroll
            for (int m = 0; m < 4; ++m)
#pragma unroll
                for (int n = 0; n < 2; ++n) acc[a][b][m][n] = (f32x4){0.f, 0.f, 0.f, 0.f};
    bf16x8 At[4][2], B0[2][2], B1[2][2];
    const char* cA = (const char*)g.A + (size_t)cur.pm * tstep; const char* cB = (const char*)g.Bt + (size_t)cur.pn * tstep;
    S.a_ready(cur);
    if constexpr (SP2) {
        PG8_STAGE(PG8_SB(0, 0), cB, voffB); PG8_STAGE(PG8_SB(0, 1), cB + hstep, voffB); PG8_STAGE(PG8_SA(0, 0), cA, voffA); PG8_STAGE(PG8_SA(0, 1), cA + hstep, voffA);
        if (wr == 1) PG8_BAR;
        PG8_WAIT_V(2); PG8_BAR;
        PG8_STAGE(PG8_SB(1, 0), cB + kstep, voffB); PG8_STAGE(PG8_SA(1, 0), cA + kstep, voffA); PG8_STAGE(PG8_SB(1, 1), cB + hstep + kstep, voffB);
        PG8_WAIT_V(6); PG8_BAR;
    } else {
        PG8_STAGE(PG8_SB(0, 0), cB, voffB); PG8_STAGE(PG8_SA(0, 0), cA, voffA); PG8_STAGE(PG8_SB(0, 1), cB + hstep, voffB); PG8_STAGE(PG8_SA(0, 1), cA + hstep, voffA);
        if (wr == 1) PG8_BAR;
        PG8_WAIT_V(4); PG8_BAR;
        PG8_STAGE(PG8_SB(1, 0), cB + kstep, voffB); PG8_STAGE(PG8_SA(1, 0), cA + kstep, voffA); PG8_STAGE(PG8_SB(1, 1), cB + hstep + kstep, voffB);
        PG8_WAIT_V(6); PG8_BAR;
    }
    for (;;) {
        const bool has_next = S.next(ui + 1, nxt);
        const char* nA = has_next ? (const char*)g.A + (size_t)nxt.pm * tstep : cA; const char* nB = has_next ? (const char*)g.Bt + (size_t)nxt.pn * tstep : cB;
        for (int t = 0; t < nt; t += 2) {
            const bool last = (t == nt - 2);
            const char* a1 = cA + (size_t)(t + 1) * kstep;
            const char* a2 = last ? nA : cA + (size_t)(t + 2) * kstep; const char* b2 = last ? nB : cB + (size_t)(t + 2) * kstep;
            const char* a3 = a2 + kstep; const char* b3 = b2 + kstep;
            if (last && has_next) S.a_ready(nxt);
            if constexpr (SP2) {
            PG8_LDB(B0, 0, 0); PG8_LDB(B1, 0, 1); PG8_SCHED; PG8_LDA(At, 0, 0); PG8_STAGE(PG8_SA(1, 1), a1 + hstep, voffA);
            PG8_WAIT_V(8); PG8_WAIT_L(0); PG8_BAR; PG8_MMA(0, 0, At, B0); PG8_MMA(0, 1, At, B1); PG8_BAR; PG8_SCHED;
            PG8_LDA(At, 0, 1); PG8_STAGE(PG8_SB(0, 0), b2, voffB); PG8_STAGE(PG8_SB(0, 1), b2 + hstep, voffB); PG8_STAGE(PG8_SA(0, 0), a2, voffA);
            PG8_WAIT_V(8); PG8_WAIT_L(0); PG8_BAR; PG8_MMA(1, 0, At, B0); PG8_MMA(1, 1, At, B1); PG8_BAR; PG8_SCHED;
            PG8_LDB(B0, 1, 0); PG8_LDB(B1, 1, 1); PG8_SCHED; PG8_LDA(At, 1, 0); PG8_STAGE(PG8_SA(0, 1), a2 + hstep, voffA);
            PG8_WAIT_V(8); PG8_WAIT_L(0); PG8_BAR; PG8_MMA(0, 0, At, B0); PG8_MMA(0, 1, At, B1); PG8_BAR; PG8_SCHED;
            PG8_LDA(At, 1, 1); PG8_STAGE(PG8_SB(1, 0), b3, voffB); PG8_STAGE(PG8_SB(1, 1), b3 + hstep, voffB); PG8_STAGE(PG8_SA(1, 0), a3, voffA);
            PG8_WAIT_V(8); PG8_WAIT_L(0); PG8_BAR; PG8_MMA(1, 0, At, B0); PG8_MMA(1, 1, At, B1); PG8_BAR; PG8_SCHED;
            } else {
            PG8_LDB(B0, 0, 0); PG8_SCHED; PG8_LDA(At, 0, 0); PG8_STAGE(PG8_SA(1, 1), a1 + hstep, voffA);
            PG8_WAIT_L(8); PG8_BAR; PG8_WAIT_L(0); PG8_MMA(0, 0, At, B0); PG8_BAR; PG8_SCHED;
            PG8_LDB(B1, 0, 1); PG8_STAGE(PG8_SB(0, 0), b2, voffB);
            PG8_BAR; PG8_WAIT_L(0); PG8_MMA(0, 1, At, B1); PG8_BAR;
            PG8_LDA(At, 0, 1); PG8_STAGE(PG8_SA(0, 0), a2, voffA);
            PG8_BAR; PG8_WAIT_L(0); PG8_MMA(1, 0, At, B0); PG8_BAR; PG8_SCHED;
            PG8_STAGE(PG8_SB(0, 1), b2 + hstep, voffB);
            PG8_WAIT_V(6); PG8_BAR; PG8_MMA(1, 1, At, B1); PG8_BAR;
            PG8_LDB(B0, 1, 0); PG8_SCHED; PG8_LDA(At, 1, 0); PG8_STAGE(PG8_SA(0, 1), a2 + hstep, voffA);
            PG8_WAIT_L(8); PG8_BAR; PG8_WAIT_L(0); PG8_MMA(0, 0, At, B0); PG8_BAR; PG8_SCHED;
            PG8_LDB(B1, 1, 1); PG8_STAGE(PG8_SB(1, 0), b3, voffB);
            PG8_BAR; PG8_WAIT_L(0); PG8_MMA(0, 1, At, B1); PG8_BAR;
            PG8_LDA(At, 1, 1); PG8_STAGE(PG8_SA(1, 0), a3, voffA);
            PG8_BAR; PG8_WAIT_L(0); PG8_MMA(1, 0, At, B0); PG8_BAR; PG8_SCHED;
            PG8_STAGE(PG8_SB(1, 1), b3 + hstep, voffB);
            PG8_WAIT_V(6); PG8_BAR; PG8_MMA(1, 1, At, B1); PG8_BAR;
            }
        }
        if constexpr (ALIGN_EPI) { if (wr == 0) PG8_BAR; }
        if constexpr (!Epi::AFTER_DRAIN) { E(acc, cur, wr, wc, fr, fq); S.done(cur); }
        if (!has_next) break;
#pragma unroll
        for (int a = 0; a < 2; ++a)
#pragma unroll
            for (int b = 0; b < 2; ++b)
#pragma unroll
                for (int m = 0; m < 4; ++m)
#pragma unroll
                    for (int n = 0; n < 2; ++n) acc[a][b][m][n] = (f32x4){0.f, 0.f, 0.f, 0.f};
        cur = nxt; cA = nA; cB = nB; ++ui;
        if constexpr (ALIGN_EPI) { if (wr == 1) PG8_BAR; }
    }
    PG8_WAIT_V(0);
    if constexpr (!ALIGN_EPI) { if (wr == 0) PG8_BAR; }
    PG8_BAR;
    if constexpr (Epi::AFTER_DRAIN) { E.fused(acc, cur, wr, wc, fr, fq, lds, wid, lane); S.done(cur); }
#undef PG8_SA
#undef PG8_SB
#undef PG8_STAGE
#undef PG8_LDA
#undef PG8_LDB
#undef PG8_MMA
#undef PG8_WAIT_V
#undef PG8_WAIT_L
#undef PG8_BAR
#undef PG8_SCHED
}
}
#define GAS __attribute__((address_space(1)))
#define LAS __attribute__((address_space(3)))
typedef unsigned short bf16;
typedef unsigned v4u __attribute__((ext_vector_type(4)));
typedef float f32x4 __attribute__((ext_vector_type(4)));
typedef short bf16x8 __attribute__((ext_vector_type(8)));
typedef GAS unsigned gu32;
typedef GAS unsigned long long gu64;
#define RLX_AGENT __ATOMIC_RELAXED, __HIP_MEMORY_SCOPE_AGENT
#define LDS_WAIT() asm volatile("s_waitcnt lgkmcnt(0)" ::: "memory")
#define VM_WAIT() asm volatile("s_waitcnt vmcnt(0)" ::: "memory")
__device__ __forceinline__ unsigned long long rt() { return __builtin_amdgcn_s_memrealtime(); }
__device__ __forceinline__ unsigned f2bf(float f) { unsigned u = __builtin_bit_cast(unsigned, f); return (u + 0x7fffu + ((u >> 16) & 1u)) >> 16; }
__device__ __forceinline__ unsigned pk2(float lo, float hi) { return f2bf(lo) | (f2bf(hi) << 16); }

#define XB_TMO      128
#define XB_XCNT(j)  (256  + 64 * (j))
#define XB_XSUB(j)  (1280 + 64 * (j))
#define XB_XGEN(j)  (2304 + 64 * (j))
#define XB_TOP      3328
#define XB_TOPGEN   3392
#define XCD_BAR_WORDS 3456
#define XB_SPIN_CAP (1u << 18)

__device__ __forceinline__ unsigned xb_ld(unsigned* p)              { return __hip_atomic_load(p, __ATOMIC_RELAXED, __HIP_MEMORY_SCOPE_AGENT); }
__device__ __forceinline__ unsigned xb_add(unsigned* p, unsigned v) { return __hip_atomic_fetch_add(p, v, __ATOMIC_RELAXED, __HIP_MEMORY_SCOPE_AGENT); }
__device__ __forceinline__ unsigned xb_xcc_id() { return (unsigned)__builtin_amdgcn_s_getreg((3 << 11) | 20) & 0xFu; }
#define XB_SPIN(cond, bar) do { unsigned _sp = 0; while (cond) { __builtin_amdgcn_s_sleep(1); \
    if ((++_sp & 255u) == 0u) { if (xb_ld(&(bar)[XB_TMO])) break; if (_sp > XB_SPIN_CAP) { atomicAdd(&(bar)[XB_TMO], 1u); break; } } } } while (0)

struct XcdBarrier {
    unsigned* bar; unsigned x;
    volatile LAS unsigned* st;
};

__device__ __forceinline__ XcdBarrier xcd_barrier_post(unsigned* bar, volatile LAS unsigned* st) {
    XcdBarrier b; b.bar = bar; b.x = xb_xcc_id(); b.st = st;
    if (threadIdx.x == 0) (void)xb_add(&bar[XB_XCNT(b.x)], 1u);
    return b;
}
__device__ __forceinline__ void xcd_barrier_complete(unsigned* bar, unsigned x, unsigned& nloc, unsigned& nx) {
    const unsigned G = gridDim.x * gridDim.y * gridDim.z;
    unsigned sum, cnt, mine, sp = 0u;
    for (;;) {
        sum = 0u; cnt = 0u; mine = 0u;
#pragma unroll
        for (unsigned j = 0; j < 16; ++j) { const unsigned c = xb_ld(&bar[XB_XCNT(j)]); sum += c; cnt += (c > 0u) ? 1u : 0u; mine = (j == x) ? c : mine; }
        if (sum == G) break;
        __builtin_amdgcn_s_sleep(1);
        if ((++sp & 255u) == 0u) { if (xb_ld(&bar[XB_TMO])) break; if (sp > XB_SPIN_CAP) { atomicAdd(&bar[XB_TMO], 1u); break; } }
    }
    nloc = mine > 0u ? mine : 1u; nx = cnt > 0u ? cnt : 1u;
}

__device__ __forceinline__ void xcd_barrier(const XcdBarrier& b) {
    asm volatile("s_waitcnt vmcnt(0)" ::: "memory");
    __syncthreads();
    if (threadIdx.x == 0) {
        unsigned* bar = b.bar;
        __builtin_amdgcn_s_waitcnt(0);
        unsigned nloc = b.st[0], nx = b.st[1];
        if (nloc == 0u) { xcd_barrier_complete(bar, b.x, nloc, nx); b.st[0] = nloc; b.st[1] = nx; }
        const unsigned old = xb_add(&bar[XB_XSUB(b.x)], 1u);
        const unsigned gen = old / nloc;
        if (old + 1u == (gen + 1u) * nloc) {
            __builtin_amdgcn_fence(__ATOMIC_RELEASE, "agent");
            asm volatile("s_waitcnt vmcnt(0)" ::: "memory");
            const unsigned og = xb_add(&bar[XB_TOP], 1u);
            const unsigned tg = og / nx;
            if (og + 1u == (tg + 1u) * nx) xb_add(&bar[XB_TOPGEN], 1u);
            else XB_SPIN(xb_ld(&bar[XB_TOPGEN]) == tg, bar);
            __builtin_amdgcn_fence(__ATOMIC_ACQUIRE, "agent");
            xb_add(&bar[XB_XGEN(b.x)], 1u);
            asm volatile("s_waitcnt vmcnt(0)" ::: "memory");
        } else {
            XB_SPIN(xb_ld(&bar[XB_XGEN(b.x)]) == gen, bar);
            __builtin_amdgcn_fence(__ATOMIC_ACQUIRE, "agent");
            asm volatile("s_waitcnt vmcnt(0)" ::: "memory");
        }
    }
    __syncthreads();
}

#ifndef PROBE_REP
#define PROBE_REP 0
#endif
#define REPS(k) (1 + ((PROBE_REP >> (k)) & 1))
constexpr int NWAVES = 8;
#ifndef MK_N_LAUNCHES
#define MK_N_LAUNCHES 1
#endif
constexpr int N_PHASES = 26;
constexpr int N_LAUNCHES = MK_N_LAUNCHES;

constexpr int TP = 16384, TS = 1024, TT = TP + TS;
constexpr int DM = 1024, DA = 384, DB = 384, DC = 256, DFF = 2816, DPLE = 256, NL = 4, DIN = 2432;
constexpr int ZN = 2560, ZLD = 1792;
constexpr int Z_CA = 0, Z_GLU = 384, Z_GB = 640, Z_U = 1024, Z_V = 1408;
constexpr int GUN = 2 * DFF;
constexpr float EPS = 1e-6f;
constexpr size_t O_Y = 0, O_NAP = 17825792, O_NAS = 17850368, O_NCP = 18243584, O_NCS = 18489344, O_NVP = 22421504, O_NVS = 23994368, O_END = 25567232;
constexpr size_t MiB = 1u << 20;
constexpr size_t WS_CTL = 0, CTL_ZERO_BYTES = 1 * MiB;
constexpr size_t WS_SS = 345 * MiB, SS_STRIDE = (size_t)17408 * 16;
constexpr size_t WS_WIN = 2 * MiB, WS_WOUT = 22 * MiB, WS_WGU = 30 * MiB, WS_WDN = 74 * MiB, WS_WPG = 96 * MiB, WS_WPP = 104 * MiB;
constexpr size_t WS_HB0 = 106 * MiB, WS_HB1 = 140 * MiB, WS_MIX = 174 * MiB, WS_PROJ = 208 * MiB, WS_PB = 242 * MiB, WS_ZACT = 251 * MiB, WS_END = 349 * MiB;
static_assert(3 * SS_STRIDE * 4 <= 4 * MiB && (size_t)NL * ZN * DM * 2 == 20 * MiB && (size_t)NL * GUN * DM * 2 == 44 * MiB && (size_t)TT * DM * 2 == 34 * MiB && (size_t)TT * DFF * 2 <= 94 * MiB && (size_t)TT * DPLE * 2 <= 9 * MiB, "d_ws map");
constexpr int CW_TMO = 0, CW_CODE = 1, CW_BAR = 4096;

constexpr int RING_OFF = 0, RING_BYTES = 131072;
constexpr int LDSCTL_OFF = RING_BYTES, MISC_OFF = LDSCTL_OFF + 320;
constexpr int LDS_BYTES = 147456;

struct Args { const float* in[29]; float* out; unsigned char* ws; int ph_lo, ph_hi; };
typedef unsigned u32x2 __attribute__((ext_vector_type(2)));
typedef short v4i16_t __attribute__((ext_vector_type(4)));

struct Frame {
    LAS unsigned char* lds;
    volatile LAS unsigned* MISC;
    gu32* ctl;
    int tid, lane, wave, G;
    float* out; unsigned char* ws;
};

__device__ __forceinline__ float row16_sum(float v) {
    v += __builtin_bit_cast(float, __builtin_amdgcn_update_dpp(0, __builtin_bit_cast(int, v), 0xB1, 0xF, 0xF, true));
    v += __builtin_bit_cast(float, __builtin_amdgcn_update_dpp(0, __builtin_bit_cast(int, v), 0x4E, 0xF, 0xF, true));
    v += __builtin_bit_cast(float, __builtin_amdgcn_update_dpp(0, __builtin_bit_cast(int, v), 0x141, 0xF, 0xF, true));
    v += __builtin_bit_cast(float, __builtin_amdgcn_update_dpp(0, __builtin_bit_cast(int, v), 0x140, 0xF, 0xF, true));
    return v;
}
__device__ __forceinline__ float wave_sum(float v) {
    v = row16_sum(v); const int iv = __builtin_bit_cast(int, v);
    const float r0 = __builtin_bit_cast(float, __builtin_amdgcn_readlane(iv, 0)), r1 = __builtin_bit_cast(float, __builtin_amdgcn_readlane(iv, 16)),
                r2 = __builtin_bit_cast(float, __builtin_amdgcn_readlane(iv, 32)), r3 = __builtin_bit_cast(float, __builtin_amdgcn_readlane(iv, 48));
    return (r0 + r1) + (r2 + r3);
}
__device__ __forceinline__ float half_sum(float v, bool upper) {
    v = row16_sum(v); const int iv = __builtin_bit_cast(int, v);
    const float r0 = __builtin_bit_cast(float, __builtin_amdgcn_readlane(iv, 0)), r1 = __builtin_bit_cast(float, __builtin_amdgcn_readlane(iv, 16)),
                r2 = __builtin_bit_cast(float, __builtin_amdgcn_readlane(iv, 32)), r3 = __builtin_bit_cast(float, __builtin_amdgcn_readlane(iv, 48));
    return upper ? (r2 + r3) : (r0 + r1);
}
__device__ __forceinline__ unsigned pk_bf16(float lo, float hi) { return pg8::cvt_pk_bf16(lo, hi); }
__device__ __forceinline__ f32x4 up4(u32x2 w) { return (f32x4){pg8::bf_lo(w.x), pg8::bf_hi(w.x), pg8::bf_lo(w.y), pg8::bf_hi(w.y)}; }
__device__ __forceinline__ u32x2 pk4(f32x4 v) { u32x2 w; w.x = pk_bf16(v[0], v[1]); w.y = pk_bf16(v[2], v[3]); return w; }

#define GL64(d, p)  asm volatile("global_load_dwordx2 %0, %1, off" : "=v"(d) : "v"(p) : "memory")
#define GL128(d, p) asm volatile("global_load_dwordx4 %0, %1, off" : "=v"(d) : "v"(p) : "memory")
#define GWAIT8(a, i) asm volatile("s_waitcnt vmcnt(0)" : "+v"(a[i]), "+v"(a[i + 1]), "+v"(a[i + 2]), "+v"(a[i + 3]), "+v"(a[i + 4]), "+v"(a[i + 5]), "+v"(a[i + 6]), "+v"(a[i + 7]) :: "memory")
#define GWAIT6(a, i) asm volatile("s_waitcnt vmcnt(0)" : "+v"(a[i]), "+v"(a[i + 1]), "+v"(a[i + 2]), "+v"(a[i + 3]), "+v"(a[i + 4]), "+v"(a[i + 5]) :: "memory")
__device__ __forceinline__ void p0_transpose_item(const float* W, int K, int N, bf16* WT, int dst_row0, const float* gain, LAS float* scr, int k0, int n0, int lane) {
#pragma unroll 8
    for (int i = 0; i < 32; ++i) { const int kk = 2 * i + (lane >> 5); float w = W[(size_t)(k0 + kk) * N + n0 + (lane & 31)]; if (gain) w *= gain[k0 + kk]; scr[kk * 33 + (lane & 31)] = w; }
    LDS_WAIT(); asm volatile("" ::: "memory");
    const int c = lane & 7;
#pragma unroll
    for (int j = 0; j < 4; ++j) { const int n = (lane >> 3) + 8 * j; const LAS float* s = scr + (8 * c) * 33 + n;
        v4u o; o.x = pk_bf16(s[0 * 33], s[1 * 33]); o.y = pk_bf16(s[2 * 33], s[3 * 33]); o.z = pk_bf16(s[4 * 33], s[5 * 33]); o.w = pk_bf16(s[6 * 33], s[7 * 33]);
        *(GAS v4u*)(WT + (size_t)(dst_row0 + n) * K + k0 + 8 * c) = o; }
    LDS_WAIT(); asm volatile("" ::: "memory");
}
__device__ __forceinline__ void convert_p(const Frame& F, const Args& A, int l, int gw, int ngw) {
    bf16* PB = (bf16*)(F.ws + WS_PB);
    for (int r = gw; r < TT; r += ngw) {
        const float* src = (r < TP) ? A.in[4] + ((size_t)l * TP + r) * DPLE : A.in[5] + ((size_t)l * TS + (r - TP)) * DPLE;
        const f32x4 v = *(const f32x4*)(src + 4 * F.lane);
        *(u32x2*)(PB + (size_t)r * DPLE + 4 * F.lane) = pk4(v);
    }
}
__device__ __forceinline__ void p0_prologue(const Frame& F, const Args& A) {
    LAS float* scr = (LAS float*)(F.lds + RING_OFF + F.wave * 16384);
    const int gw = blockIdx.x * NWAVES + F.wave, NGW = F.G * NWAVES;
    constexpr int I_IN = 16 * 76, I_OUT = 16 * 32, I_G = 16 * 88, I_DN = 44 * 32, I_PG = 16 * 32, I_PP = 4 * 32;
    constexpr int I_LAYER = I_IN + I_OUT + 2 * I_G + I_DN + I_PG + I_PP;
    for (int it = gw; it < NL * I_LAYER; it += NGW) {
        const int l = it / I_LAYER; int r = it % I_LAYER;
        if (r < I_IN) { const int kb = r / 76, nb = r % 76, n0 = 32 * nb, sb = n0 >> 7;
            const int kd = sb < 3 ? 2 * sb : sb < 6 ? sb + 7 : sb < 9 ? 2 * sb - 11 : sb < 15 ? sb + 4 : sb < 17 ? 2 * sb - 24 : 2 * sb - 27;
            p0_transpose_item(A.in[7] + (size_t)l * DM * DIN, DM, DIN, (bf16*)(F.ws + WS_WIN) + (size_t)l * ZN * DM, kd * 128 + (n0 & 127), A.in[6] + l * DM, scr, 64 * kb, n0, F.lane); continue; } r -= I_IN;
        if (r < I_OUT) { const int kb = r / 32, nb = r % 32, k0 = 64 * kb;
            const float* g = k0 < DA ? A.in[17] + l * DA : k0 < DA + DB ? A.in[18] + l * DB - DA : A.in[19] + l * DC - (DA + DB);
            p0_transpose_item(A.in[20] + (size_t)l * DM * DM, DM, DM, (bf16*)(F.ws + WS_WOUT) + (size_t)l * DM * DM, 32 * nb, g, scr, k0, 32 * nb, F.lane); continue; } r -= I_OUT;
        if (r < 2 * I_G) { const int up = r >= I_G; if (up) r -= I_G; const int kb = r / 88, nb = r % 88, n0 = 32 * nb;
            p0_transpose_item((up ? A.in[23] : A.in[22]) + (size_t)l * DM * DFF, DM, DFF, (bf16*)(F.ws + WS_WGU) + (size_t)l * GUN * DM, (n0 >> 7) * 256 + up * 128 + (n0 & 127), A.in[21] + l * DM, scr, 64 * kb, n0, F.lane); continue; } r -= 2 * I_G;
        if (r < I_DN) { const int kb = r / 32, nb = r % 32;
            p0_transpose_item(A.in[24] + (size_t)l * DFF * DM, DFF, DM, (bf16*)(F.ws + WS_WDN) + (size_t)l * DM * DFF, 32 * nb, nullptr, scr, 64 * kb, 32 * nb, F.lane); continue; } r -= I_DN;
        if (r < I_PG) { const int kb = r / 32, nb = r % 32;
            p0_transpose_item(A.in[26] + (size_t)l * DM * DM, DM, DM, (bf16*)(F.ws + WS_WPG) + (size_t)l * DM * DM, 32 * nb, A.in[25] + l * DM, scr, 64 * kb, 32 * nb, F.lane); continue; } r -= I_PG;
        { const int kb = r / 32, nb = r % 32;
            p0_transpose_item(A.in[27] + (size_t)l * DPLE * DM, DPLE, DM, (bf16*)(F.ws + WS_WPP) + (size_t)l * DM * DPLE, 32 * nb, nullptr, scr, 64 * kb, 32 * nb, F.lane); }
    }
    bf16* HB0 = (bf16*)(F.ws + WS_HB0); float* ss0 = (float*)(F.ws + WS_SS);
    for (int m = gw; m < TT; m += NGW) {
        const float* xr = (m < TP) ? A.in[0] + (size_t)m * DM : A.in[1] + (size_t)(m - TP) * DM;
        float s = 0.f;
#pragma unroll
        for (int j = 0; j < 4; ++j) { const f32x4 v = *(const f32x4*)(xr + 256 * j + 4 * F.lane); s += pg8::sumsq4(v); *(u32x2*)(HB0 + (size_t)m * DM + 256 * j + 4 * F.lane) = pk4(v); }
        s = wave_sum(s); if (F.lane < 16) ss0[(size_t)m * 16 + F.lane] = (F.lane == 0) ? s : 0.f;
    }
    convert_p(F, A, 0, gw, NGW);
}

__device__ __forceinline__ void mix_a(const Frame& F, const Args& A, int l, int c) {
    const bf16* ZB = (const bf16*)(F.ws + WS_ZACT); bf16* MIX = (bf16*)(F.ws + WS_MIX);
    int tid_ = F.tid; asm volatile("" : "+v"(tid_)); const int hw = tid_ >> 5, l32 = tid_ & 31; const int r0 = 128 * c + 8 * hw; const bool samp = (c >= 128);
    const float* cw = A.in[8] + (size_t)l * 3 * DA;
    f32x4 w0[3], w1[3], w2[3], p2[3], p1[3];
    const int q = samp ? (r0 - TP) >> 3 : 0;
#pragma unroll
    for (int i = 0; i < 3; ++i) { const int col = 4 * (l32 + 32 * i);
        w0[i] = *(const f32x4*)(cw + col); w1[i] = *(const f32x4*)(cw + DA + col); w2[i] = *(const f32x4*)(cw + 2 * DA + col);
        if (samp) { const float* st = A.in[2] + ((size_t)(l * 128 + q) * 2) * DA; p2[i] = *(const f32x4*)(st + col); p1[i] = *(const f32x4*)(st + DA + col); }
        else if (((c & 15) == 0) && hw == 0) { p2[i] = (f32x4){0.f, 0.f, 0.f, 0.f}; p1[i] = p2[i]; }
        else { p2[i] = up4(*(const u32x2*)(ZB + (size_t)(r0 - 2) * ZLD + Z_CA + col)); p1[i] = up4(*(const u32x2*)(ZB + (size_t)(r0 - 1) * ZLD + Z_CA + col)); } }
#pragma unroll
    for (int rr = 0; rr < 8; ++rr) { const int row = r0 + rr; f32x4 cur[3], y[3]; float s = 0.f;
#pragma unroll
        for (int i = 0; i < 3; ++i) { const int col = 4 * (l32 + 32 * i);
            cur[i] = up4(*(const u32x2*)(ZB + (size_t)row * ZLD + Z_CA + col)); const f32x4 gb = up4(*(const u32x2*)(ZB + (size_t)row * ZLD + Z_GB + col));
            y[i] = gb * (w0[i] * p2[i] + w1[i] * p1[i] + w2[i] * cur[i]); s += pg8::sumsq4(y[i]); }
        s = half_sum(s, (hw & 1) != 0);
        const float rs = rsqrtf(s * (1.0f / DA) + EPS);
#pragma unroll
        for (int i = 0; i < 3; ++i) { const int col = 4 * (l32 + 32 * i);
            *(u32x2*)(MIX + (size_t)row * DM + col) = pk4(y[i] * rs);
            if (rr >= 6) { if (samp) *(f32x4*)(F.out + O_NAS + ((size_t)(l * 128 + q) * 2 + (rr - 6)) * DA + col) = cur[i];
                           else if ((c & 15) == 15 && hw == 15) *(f32x4*)(F.out + O_NAP + ((size_t)(l * 8 + (c >> 4)) * 2 + (rr - 6)) * DA + col) = cur[i]; }
            p2[i] = p1[i]; p1[i] = cur[i]; }
    }
}
__device__ __forceinline__ void mix_c(const Frame& F, const Args& A, int l, int c) {
    const bf16* ZB = (const bf16*)(F.ws + WS_ZACT); bf16* MIX = (bf16*)(F.ws + WS_MIX);
    int lane_ = F.lane; asm volatile("" : "+v"(lane_));
    const bool samp = (c >= 128); const int col = 4 * lane_;
    const float* cw = A.in[13] + (size_t)l * 31 * DC + col;
    const f32x4 bias = *(const f32x4*)(A.in[14] + l * DC + col), lg = *(const f32x4*)(A.in[15] + l * DC + col), lb = *(const f32x4*)(A.in[16] + l * DC + col);
    const f32x4 zero4 = (f32x4){0.f, 0.f, 0.f, 0.f};
#pragma unroll 1
    for (int hb = 0; hb < 2; ++hb) {
        const int rb = 16 * F.wave + 8 * hb;
        const int q = samp ? 16 * (c - 128) + 2 * F.wave + hb : 0;
        const float* st = A.in[3] + ((size_t)(l * 128 + q) * 30) * DC + col;
        const bf16* zb = ZB + ((size_t)128 * c + rb) * ZLD + Z_GLU + col;
        const int t0 = 128 * (c & 15) + rb - 30;
        u32x2 xp[38];
        if (samp) {
#pragma unroll
            for (int i = 30; i < 38; ++i) GL64(xp[i], zb + (size_t)(i - 30) * ZLD);
#pragma unroll
            for (int hf = 0; hf < 3; ++hf) { f32x4 xs[10];
#pragma unroll
                for (int i = 0; i < 10; ++i) GL128(xs[i], st + (size_t)(10 * hf + i) * DC);
                asm volatile("s_waitcnt vmcnt(0)" : "+v"(xs[0]), "+v"(xs[1]), "+v"(xs[2]), "+v"(xs[3]), "+v"(xs[4]), "+v"(xs[5]), "+v"(xs[6]), "+v"(xs[7]), "+v"(xs[8]), "+v"(xs[9]) :: "memory");
#pragma unroll
                for (int i = 0; i < 10; ++i) xp[10 * hf + i] = pk4(xs[i]); }
            GWAIT8(xp, 30);
        } else {
#pragma unroll
            for (int i = 0; i < 38; ++i) { const ptrdiff_t ri = (t0 + i >= 0) ? (ptrdiff_t)i - 30 : 0; GL64(xp[i], zb + ri * ZLD); }
            GWAIT8(xp, 0); GWAIT8(xp, 8); GWAIT8(xp, 16); GWAIT8(xp, 24); GWAIT6(xp, 32);
#pragma unroll
            for (int i = 0; i < 38; ++i) if (t0 + i < 0) { xp[i].x = 0u; xp[i].y = 0u; }
        }
        f32x4 acc[8];
#pragma unroll
        for (int o = 0; o < 8; ++o) acc[o] = zero4;
#pragma unroll
        for (int kb = 0; kb < 8; ++kb) {
            f32x4 wv[4];
#pragma unroll
            for (int kk = 0; kk < 4; ++kk) { const int k = 4 * kb + kk; wv[kk] = (k <= 30) ? *(const f32x4*)(cw + (size_t)k * DC) : zero4; }
            f32x4 xw[11];
#pragma unroll
            for (int j = 0; j < 11; ++j) { const int i = 4 * kb + j; xw[j] = (i <= 37) ? up4(xp[i]) : zero4; }
#pragma unroll
            for (int kk = 0; kk < 4; ++kk)
#pragma unroll
                for (int o = 0; o < 8; ++o) acc[o] += wv[kk] * xw[o + kk];
            __builtin_amdgcn_sched_barrier(0);
        }
#pragma unroll
        for (int o = 0; o < 8; ++o) { const int row = 128 * c + rb + o;
            const f32x4 v = acc[o] + bias; const float mean = wave_sum((v[0] + v[1]) + (v[2] + v[3])) * (1.0f / DC);
            const f32x4 d = v - mean; const float rstd = rsqrtf(wave_sum(pg8::sumsq4(d)) * (1.0f / DC) + EPS);
            const f32x4 yn = d * rstd * lg + lb; const f32x4 y = yn * pg8::sigm4(yn);
            const float rs = rsqrtf(wave_sum(pg8::sumsq4(y)) * (1.0f / DC) + EPS);
            *(u32x2*)(MIX + (size_t)row * DM + DA + DB + col) = pk4(y * rs); }
        if (samp) { float* onc = F.out + O_NCS + ((size_t)(l * 128 + q) * 30) * DC + col;
#pragma unroll 2
            for (int i = 0; i < 22; ++i) *(f32x4*)(onc + (size_t)i * DC) = *(const f32x4*)(st + (size_t)(8 + i) * DC);
#pragma unroll 2
            for (int o = 0; o < 8; ++o) *(f32x4*)(onc + (size_t)(22 + o) * DC) = up4(*(const u32x2*)(zb + (size_t)o * ZLD)); }
        else if ((c & 15) == 15) { float* onc = F.out + O_NCP + ((size_t)(l * 8 + (c >> 4)) * 30) * DC + col;
#pragma unroll 2
            for (int o = 0; o < 8; ++o) if (rb + o >= 98) *(f32x4*)(onc + (size_t)(rb + o - 98) * DC) = up4(*(const u32x2*)(zb + (size_t)o * ZLD)); }
    }
}
__device__ __forceinline__ void mix_b(const Frame& F, const Args& A, int l, int c) {
    const bf16* ZB = (const bf16*)(F.ws + WS_ZACT); bf16* MIX = (bf16*)(F.ws + WS_MIX);
    constexpr int VS = 392;
    LAS bf16* vn = (LAS bf16*)(F.lds + RING_OFF);
    const bool samp = (c >= 128); int lane_ = F.lane; asm volatile("" : "+v"(lane_)); const int w = F.wave, lane = lane_;
    {
        const bool act = lane < 48; const int col = 8 * (act ? lane : 0);
        f32x4 g0 = *(const f32x4*)(A.in[9] + l * DB + col), g1 = *(const f32x4*)(A.in[9] + l * DB + col + 4), b0 = *(const f32x4*)(A.in[10] + l * DB + col), b1 = *(const f32x4*)(A.in[10] + l * DB + col + 4);
        v4u pvs[16];
#pragma unroll
        for (int rr = 0; rr < 16; ++rr) pvs[rr] = *(const v4u*)(ZB + (size_t)(128 * c + 16 * w + rr) * ZLD + Z_V + col);
#pragma unroll
        for (int rr = 0; rr < 16; ++rr) { const int rowc = 16 * w + rr, row = 128 * c + rowc;
            const v4u pv = pvs[rr];
            f32x4 v0 = (f32x4){pg8::bf_lo(pv.x), pg8::bf_hi(pv.x), pg8::bf_lo(pv.y), pg8::bf_hi(pv.y)}, v1 = (f32x4){pg8::bf_lo(pv.z), pg8::bf_hi(pv.z), pg8::bf_lo(pv.w), pg8::bf_hi(pv.w)};
            float s = (v0[0] + v0[1]) + (v0[2] + v0[3]) + (v1[0] + v1[1]) + (v1[2] + v1[3]); if (!act) s = 0.f;
            const float mean = wave_sum(s) * (1.0f / DB);
            v0 = v0 - mean; v1 = v1 - mean; float qv = pg8::sumsq4(v0) + pg8::sumsq4(v1); if (!act) qv = 0.f;
            const float rstd = rsqrtf(wave_sum(qv) * (1.0f / DB) + EPS);
            v0 = v0 * rstd * g0 + b0; v1 = v1 * rstd * g1 + b1;
            if (act) { v4u o; o.x = pk_bf16(v0[0], v0[1]); o.y = pk_bf16(v0[2], v0[3]); o.z = pk_bf16(v1[0], v1[1]); o.w = pk_bf16(v1[2], v1[3]);
                *(LAS v4u*)(vn + rowc * VS + col) = o;
                if (samp) { float* o7 = F.out + O_NVS + ((size_t)l * TS + (row - TP)) * DB + col; *(f32x4*)o7 = v0; *(f32x4*)(o7 + 4) = v1; }
                else if ((c & 15) == 15) { float* o6 = F.out + O_NVP + ((size_t)(l * 8 + (c >> 4)) * 128 + rowc) * DB + col; *(f32x4*)o6 = v0; *(f32x4*)(o6 + 4) = v1; } }
        }
    }
    __syncthreads();
    f32x4 acc[6][4];
#pragma unroll
    for (int h = 0; h < 6; ++h)
#pragma unroll
        for (int mt = 0; mt < 4; ++mt) acc[h][mt] = (f32x4){0.f, 0.f, 0.f, 0.f};
    const int t = 16 * w + (lane & 15), g = lane >> 4, q4 = (lane & 15) >> 2, p = lane & 3;
    const int ks_lo = samp ? (w >> 1) : 0, ks_hi = w >> 1;
    const int tp = samp ? (t & 7) : t;
    const bool bvalid = samp ? (g == 2 * (w & 1) + ((lane & 15) >> 3)) : true;
    const int row = 128 * c + t;
    const float* wbase = A.in[11] + ((size_t)(l * 6) * 128 + tp) * 128 + (samp ? 0 : 8 * g);
    f32x4 wa[6], wb[6];
#pragma unroll
    for (int h = 0; h < 6; ++h) { const float* wp = wbase + (size_t)h * 128 * 128 + (samp ? 0 : 32 * ks_lo); wa[h] = *(const f32x4*)wp; wb[h] = *(const f32x4*)(wp + 4); }
#pragma unroll 1
    for (int ks = ks_lo; ks <= ks_hi; ++ks) {
        const int s0 = samp ? 0 : 32 * ks + 8 * g;
        f32x4 na[6], nb[6];
        const int ksn = ks < ks_hi ? ks + 1 : ks;
#pragma unroll
        for (int h = 0; h < 6; ++h) { const float* wp = wbase + (size_t)h * 128 * 128 + (samp ? 0 : 32 * ksn); na[h] = *(const f32x4*)wp; nb[h] = *(const f32x4*)(wp + 4); }
#pragma unroll
        for (int h = 0; h < 6; ++h) {
            const f32x4 a = wa[h], b = wb[h];
            float wv[8] = {a[0], a[1], a[2], a[3], b[0], b[1], b[2], b[3]};
#pragma unroll
            for (int j = 0; j < 8; ++j) wv[j] = (bvalid && (s0 + j <= tp)) ? wv[j] : 0.f;
            bf16x8 bfrag; { v4u o; o.x = pk_bf16(wv[0], wv[1]); o.y = pk_bf16(wv[2], wv[3]); o.z = pk_bf16(wv[4], wv[5]); o.w = pk_bf16(wv[6], wv[7]); bfrag = __builtin_bit_cast(bf16x8, o); }
#pragma unroll
            for (int mt = 0; mt < 4; ++mt) { const int d0 = 64 * h + 16 * mt;
                const LAS bf16* ap = vn + (32 * ks + 8 * g + q4) * VS + d0 + 4 * p;
                const v4i16_t lo = __builtin_amdgcn_ds_read_tr16_b64_v4i16((LAS v4i16_t*)ap), hi = __builtin_amdgcn_ds_read_tr16_b64_v4i16((LAS v4i16_t*)(ap + 4 * VS));
                bf16x8 afrag; afrag[0] = lo[0]; afrag[1] = lo[1]; afrag[2] = lo[2]; afrag[3] = lo[3]; afrag[4] = hi[0]; afrag[5] = hi[1]; afrag[6] = hi[2]; afrag[7] = hi[3];
                acc[h][mt] = __builtin_amdgcn_mfma_f32_16x16x32_bf16(afrag, bfrag, acc[h][mt], 0, 0, 0); }
        }
#pragma unroll
        for (int h = 0; h < 6; ++h) { wa[h] = na[h]; wb[h] = nb[h]; }
    }
    float qs = 0.f;
#pragma unroll
    for (int h = 0; h < 6; ++h) { const float bs = A.in[12][(size_t)(l * 6 + h) * 128 + tp];
#pragma unroll
        for (int mt = 0; mt < 4; ++mt) { const f32x4 u4 = up4(*(const u32x2*)(ZB + (size_t)row * ZLD + Z_U + 64 * h + 16 * mt + 4 * g)); acc[h][mt] = u4 * (acc[h][mt] + bs); qs += pg8::sumsq4(acc[h][mt]); } }
    qs += __shfl_xor(qs, 16); qs += __shfl_xor(qs, 32);
    const float rs = rsqrtf(qs * (1.0f / DB) + EPS);
#pragma unroll
    for (int h = 0; h < 6; ++h)
#pragma unroll
        for (int mt = 0; mt < 4; ++mt) *(u32x2*)(MIX + (size_t)row * DM + DA + 64 * h + 16 * mt + 4 * g) = pk4(acc[h][mt] * rs);
    __syncthreads();
}
__device__ __forceinline__ void mixer_phase(const Frame& F, const Args& A, int l) {
    for (int u = blockIdx.x; u < 3 * 136; u += F.G) {
        if (u < 136) { for (int r = 0; r < REPS(8); ++r) mix_b(F, A, l, u); } else if (u < 272) { for (int r = 0; r < REPS(9); ++r) mix_c(F, A, l, u - 136); } else { for (int r = 0; r < REPS(10); ++r) mix_a(F, A, l, u - 272); }
    }
    if (l + 1 < NL) convert_p(F, A, l + 1, blockIdx.x * NWAVES + F.wave, F.G * NWAVES);
}
__device__ __forceinline__ void final_phase(const Frame& F, const Args& A) {
    const float* ss = (const float*)(F.ws + WS_SS);
    for (int m = blockIdx.x * NWAVES + F.wave; m < TT; m += F.G * NWAVES) {
        const float rs = rsqrtf(pg8::row_ss(ss, m) * (1.0f / DM) + EPS); float* hr = F.out + (size_t)m * DM;
#pragma unroll
        for (int j = 0; j < 4; ++j) { const int col = 256 * j + 4 * F.lane; const f32x4 v = *(const f32x4*)(hr + col), gg = *(const f32x4*)(A.in[28] + col); *(f32x4*)(hr + col) = v * rs * gg; }
    }
}

__global__ void __launch_bounds__(NWAVES * 64, 2) mk_fwd(Args args) {
    extern __shared__ __attribute__((aligned(16))) unsigned char lds[];
    Frame F;
    F.lds = (LAS unsigned char*)lds; F.MISC = (volatile LAS unsigned*)(F.lds + MISC_OFF);
    F.tid = threadIdx.x; F.lane = F.tid & 63; F.wave = __builtin_amdgcn_readfirstlane(F.tid >> 6); F.G = gridDim.x;
    F.out = args.out; F.ws = args.ws; F.ctl = (gu32*)(args.ws + WS_CTL);
    for (int u = F.tid; u < (LDS_BYTES - LDSCTL_OFF) / 4; u += NWAVES * 64) ((LAS unsigned*)(F.lds + LDSCTL_OFF))[u] = 0u;
    __syncthreads();
    XcdBarrier bar; bar.bar = (unsigned*)(F.ctl + CW_BAR); bar.x = 0; bar.st = nullptr;
    if (N_LAUNCHES == 1) bar = xcd_barrier_post((unsigned*)(F.ctl + CW_BAR), F.MISC + 8);
    const int lo = args.ph_lo, hi = args.ph_hi;
#define IN(k) (lo <= (k) && (k) < hi)
#define SEAM(k) do { if (IN(k) && IN((k) + 1)) xcd_barrier(bar); } while (0)
    float* ssb = (float*)(args.ws + WS_SS);
    bf16* ZB = (bf16*)(args.ws + WS_ZACT); bf16* ACT = ZB; bf16* MIX = (bf16*)(args.ws + WS_MIX); bf16* PROJ = (bf16*)(args.ws + WS_PROJ); bf16* PB = (bf16*)(args.ws + WS_PB);

#define GP(EPI) pg8::gemm_phase<pg8::EPI, pg8::StaticOrder, true, true>(F.lds + RING_OFF, g, S, E)
    if (IN(0)) { for (int r = 0; r < REPS(0); ++r) { if (r) xcd_barrier(bar); p0_prologue(F, args); } } SEAM(0);
#pragma unroll 1
    for (int l = 0; l < NL; ++l) {
        const int pb = 1 + 6 * l; bf16* hcur = (bf16*)(args.ws + ((l & 1) ? WS_HB1 : WS_HB0)); bf16* hnxt = (bf16*)(args.ws + ((l & 1) ? WS_HB0 : WS_HB1));
        float* ssA = ssb; float* ssB = ssb + SS_STRIDE; float* ssC = ssb + 2 * SS_STRIDE;
        if (IN(pb)) {
            for (int r = 0; r < REPS(1); ++r) { if (r) xcd_barrier(bar);
              pg8::Gemm g{hcur, (bf16*)(args.ws + WS_WIN) + (size_t)l * ZN * DM, TT, ZN, DM}; pg8::StaticOrder S; S.init(TT, ZN, F.G, (int)blockIdx.x);
              pg8::EpiZ E{ZB, ssA, ZLD}; GP(EpiZ); }
            for (int r = 0; r < REPS(2); ++r) { if (r) xcd_barrier(bar);
              pg8::Gemm g{PB, (bf16*)(args.ws + WS_WPP) + (size_t)l * DM * DPLE, TT, DM, DPLE}; pg8::StaticOrder S; S.init(TT, DM, F.G, F.G == 256 ? (int)((blockIdx.x + 88u) & 255u) : (int)blockIdx.x);
              pg8::EpiPlain E{PROJ, DM}; GP(EpiPlain); }
        } SEAM(pb);
        if (IN(pb + 1)) { for (int r = 0; r < REPS(3); ++r) { if (r) xcd_barrier(bar); mixer_phase(F, args, l); } } SEAM(pb + 1);
        if (IN(pb + 2)) {
            for (int r = 0; r < REPS(4); ++r) { if (r) xcd_barrier(bar);
              pg8::Gemm g{MIX, (bf16*)(args.ws + WS_WOUT) + (size_t)l * DM * DM, TT, DM, DM}; pg8::StaticOrder S; S.init(TT, DM, F.G, (int)blockIdx.x);
              pg8::EpiRes E{(l == 0 && r == 0) ? args.in[0] : F.out, (l == 0 && r == 0) ? args.in[1] : F.out + (size_t)TP * DM, F.out, hnxt, ssB, r ? 0.f : 1.f}; GP(EpiRes); }
        } SEAM(pb + 2);
        if (IN(pb + 3)) {
            for (int r = 0; r < REPS(5); ++r) { if (r) xcd_barrier(bar);
              pg8::Gemm g{hnxt, (bf16*)(args.ws + WS_WGU) + (size_t)l * GUN * DM, TT, GUN, DM}; pg8::StaticOrder S; S.init(TT, GUN, F.G, (int)blockIdx.x);
              pg8::EpiGU E{ACT, ssB, DFF}; GP(EpiGU); }
        } SEAM(pb + 3);
        if (IN(pb + 4)) {
            for (int r = 0; r < REPS(6); ++r) { if (r) xcd_barrier(bar);
              pg8::Gemm g{ACT, (bf16*)(args.ws + WS_WDN) + (size_t)l * DM * DFF, TT, DM, DFF}; pg8::StaticOrder S; S.init(TT, DM, F.G, (int)blockIdx.x);
              pg8::EpiRes E{F.out, F.out + (size_t)TP * DM, F.out, hcur, ssC, r ? 0.f : 1.f}; GP(EpiRes); }
        } SEAM(pb + 4);
        if (IN(pb + 5)) {
            for (int r = 0; r < REPS(7); ++r) { if (r) xcd_barrier(bar);
              pg8::Gemm g{hcur, (bf16*)(args.ws + WS_WPG) + (size_t)l * DM * DM, TT, DM, DM}; pg8::StaticOrder S; S.init(TT, DM, F.G, (int)blockIdx.x);
              pg8::EpiPle E{F.out, hnxt, PROJ, ssC, ssA, r ? 0.f : 1.f}; GP(EpiPle); }
        } SEAM(pb + 5);
    }
    if (IN(25)) final_phase(F, args);
#undef IN
#undef SEAM
}

extern "C" void kernel_launch(void* const* d_in, const int* in_sizes, int n_in, void* d_out, int out_size, void* d_ws, size_t ws_size, hipStream_t stream) {
    static int grid = 0;
    if (grid == 0) {
        if (n_in != 29 || in_sizes[0] != TP * DM || (size_t)out_size != O_END || ws_size < WS_END) { fprintf(stderr, "kernel_launch: unexpected shapes: n_in %d in0 %d out %d ws %zu (need %zu)\n", n_in, n_in > 0 ? in_sizes[0] : -1, out_size, ws_size, (size_t)WS_END); grid = -1; return; }
        int dev = 0, cus = 0, per_cu = 0;
        if (hipGetDevice(&dev) != hipSuccess || hipDeviceGetAttribute(&cus, hipDeviceAttributeMultiprocessorCount, dev) != hipSuccess) { grid = -1; return; }
        if (hipFuncSetAttribute((const void*)mk_fwd, hipFuncAttributeMaxDynamicSharedMemorySize, LDS_BYTES) != hipSuccess) { fprintf(stderr, "kernel_launch: hipFuncSetAttribute failed\n"); grid = -1; return; }
        if (hipOccupancyMaxActiveBlocksPerMultiprocessor(&per_cu, (const void*)mk_fwd, NWAVES * 64, LDS_BYTES) != hipSuccess || per_cu < 1) fprintf(stderr, "kernel_launch: occupancy query reports %d blocks per CU\n", per_cu);
        (void)hipGetLastError();
        grid = cus;
        if (grid != 256) fprintf(stderr, "kernel_launch: %d CUs (tuned for 256)\n", grid);
    }
    if (grid < 0) return;
    if (hipMemsetAsync((char*)d_ws + WS_CTL, 0, CTL_ZERO_BYTES, stream) != hipSuccess) { fprintf(stderr, "kernel_launch: memset failed\n"); return; }
    Args a{};
    for (int i = 0; i < 29; ++i) a.in[i] = (const float*)d_in[i];
    a.out = (float*)d_out; a.ws = (unsigned char*)d_ws;
    if (N_LAUNCHES == 1) { a.ph_lo = 0; a.ph_hi = N_PHASES; hipLaunchKernelGGL(mk_fwd, dim3(grid), dim3(NWAVES * 64), LDS_BYTES, stream, a); }
    else for (int p = 0; p < N_PHASES; ++p) { a.ph_lo = p; a.ph_hi = p + 1; hipLaunchKernelGGL(mk_fwd, dim3(grid), dim3(NWAVES * 64), LDS_BYTES, stream, a); }
}
```
